# Optimizing an MI355X kernel written in HIP

```python
import jax, jax.numpy as jnp
from jax import lax
import numpy as np

D_MODEL = 1024
BATCH = 4
SEQ = 4096
DEPTH = 4

N_MIXERS = 3
N_LAYERS_A = (DEPTH + 2) // 3
N_LAYERS_B = (DEPTH + 1) // 3
N_LAYERS_C = DEPTH // 3

EPS = 1e-6
NEG = -1e30
FORCE = 1e30
D_FF = 2816
FFN_RESID = 0.5
MOBA_HEADS = 16
MOBA_HEAD_DIM = D_MODEL // MOBA_HEADS
MOBA_BLOCK = 256
MOBA_TOPK = 3
MOBA_Q_CHUNK = 32
LRU_WIDTH = D_MODEL
LRU_BLOCKS = 4
LRU_BLOCK_W = LRU_WIDTH // LRU_BLOCKS
CONV_WIDTH = 4
LRU_C = 8.0
NSA_HEADS = 16
NSA_KV_GROUPS = 4
NSA_HEAD_DIM = 64
NSA_HPG = NSA_HEADS // NSA_KV_GROUPS
NSA_CMP_BLOCK = 32
NSA_CMP_STRIDE = 16
NSA_SEL_BLOCK = 64
NSA_TOPN = 16
NSA_LOCAL_BLOCKS = 2
NSA_WINDOW = 512
NSA_CMP_HIDDEN = 256
NSA_Q_CHUNK = 64
NSA_N_BRANCH = 3
NSA_KV_W = NSA_KV_GROUPS * NSA_HEAD_DIM
NSA_IN_WIDTH = NSA_HEADS * NSA_HEAD_DIM + 6 * NSA_KV_W + NSA_N_BRANCH * NSA_HEADS

kernel_name = "hybrid_moba_rglru_nsa_macaron"

F32 = jnp.float32


def rms_norm(x, g):
    xf = x.astype(F32)
    y = xf * lax.rsqrt(jnp.mean(xf * xf, axis=-1, keepdims=True) + EPS)
    return (y * g.astype(F32)).astype(x.dtype)


def swiglu_ffn(x, w_in, w_out):
    gate, up = jnp.split(x @ w_in, 2, axis=-1)
    return (jax.nn.silu(gate) * up) @ w_out


def moba_mixer(x, w_in, q_gain, k_gain, w_out):
    B, S, _ = x.shape
    H, hd, BS, Qc = MOBA_HEADS, MOBA_HEAD_DIM, MOBA_BLOCK, MOBA_Q_CHUNK
    nb = -(-S // BS)
    s_pad = nb * BS
    n_sel = min(MOBA_TOPK, nb)
    scale = hd ** -0.5
    q, k, v = jnp.split(x @ w_in, 3, axis=-1)
    q = rms_norm(q.reshape(B, S, H, hd), q_gain)
    k = rms_norm(k.reshape(B, S, H, hd), k_gain)
    v = v.reshape(B, S, H, hd)
    pad = ((0, 0), (0, s_pad - S), (0, 0), (0, 0))
    k_blk = jnp.pad(k, pad).reshape(B, nb, BS, H, hd).transpose(0, 3, 1, 2, 4)
    v_blk = jnp.pad(v, pad).reshape(B, nb, BS, H, hd).transpose(0, 3, 1, 2, 4)
    k_mean = jnp.mean(k_blk.astype(F32), axis=3).astype(k.dtype)
    n_chunks = S // Qc
    q_chunks = q.reshape(B, n_chunks, Qc, H, hd).transpose(1, 0, 3, 2, 4)
    b_ix = jnp.arange(B)[:, None, None, None]
    h_ix = jnp.arange(H)[None, :, None, None]
    blk_ids = jnp.arange(nb)

    def attend_chunk(args):
        ci, qc = args
        t0 = ci * Qc
        own = t0 // BS
        pos = t0 + jnp.arange(Qc)
        gate = jnp.einsum('bhqd,bhnd->bhqn', qc, k_mean, preferred_element_type=F32)
        gate = jnp.where(blk_ids < own, gate, NEG)
        _, sel = lax.top_k(gate, n_sel)
        sel_ok = sel < own
        k_sel = k_blk[b_ix, h_ix, sel]
        v_sel = v_blk[b_ix, h_ix, sel]
        k_own = lax.dynamic_index_in_dim(k_blk, own, axis=2, keepdims=False)
        v_own = lax.dynamic_index_in_dim(v_blk, own, axis=2, keepdims=False)
        s_own = jnp.einsum('bhqd,bhkd->bhqk', qc, k_own, preferred_element_type=F32) * scale
        own_mask = (own * BS + jnp.arange(BS))[None, :] <= pos[:, None]
        s_own = jnp.where(own_mask, s_own, NEG)
        s_sel = jnp.einsum('bhqd,bhqnkd->bhqnk', qc, k_sel, preferred_element_type=F32) * scale
        s_sel = jnp.where(sel_ok[..., None], s_sel, NEG).reshape(B, H, Qc, n_sel * BS)
        p = jax.nn.softmax(jnp.concatenate([s_own, s_sel], axis=-1), axis=-1).astype(v_blk.dtype)
        p_own = p[..., :BS]
        p_sel = p[..., BS:].reshape(B, H, Qc, n_sel, BS)
        return (jnp.einsum('bhqk,bhkd->bhqd', p_own, v_own)
                + jnp.einsum('bhqnk,bhqnkd->bhqd', p_sel, v_sel))

    o = lax.map(attend_chunk, (jnp.arange(n_chunks), q_chunks))
    o = o.transpose(1, 0, 3, 2, 4).reshape(B, S, H * hd)
    return o @ w_out


def _linear_recurrence(c1, c2):
    a1, b1 = c1
    a2, b2 = c2
    return a1 * a2, a2 * b1 + b2


def rglru_mixer(x, w_in, conv_w, conv_b, wa, ba, wx, bx, lam, w_out):
    B, S, _ = x.shape
    xb, yb = jnp.split(x @ w_in, 2, axis=-1)
    y = jax.nn.gelu(yb)
    xc = lax.conv_general_dilated(xb, conv_w, window_strides=(1,), padding=[(CONV_WIDTH - 1, 0)],
                                  dimension_numbers=('NWC', 'WIO', 'NWC'),
                                  feature_group_count=LRU_WIDTH) + conv_b
    xblk = xc.reshape(B, S, LRU_BLOCKS, LRU_BLOCK_W)
    r = jax.nn.sigmoid(jnp.einsum('bsnc,ncd->bsnd', xblk, wa).reshape(B, S, LRU_WIDTH) + ba).astype(F32)
    i = jax.nn.sigmoid(jnp.einsum('bsnc,ncd->bsnd', xblk, wx).reshape(B, S, LRU_WIDTH) + bx).astype(F32)
    log_a = -LRU_C * r * jax.nn.softplus(-lam.astype(F32))
    a = jnp.exp(log_a)
    mult = jnp.sqrt(-jnp.expm1(2.0 * log_a))
    mult = jnp.where((jnp.arange(S) == 0)[None, :, None], 1.0, mult)
    b = mult * i * xc.astype(F32)
    _, h = lax.associative_scan(_linear_recurrence, (a, b), axis=1)
    return (h.astype(x.dtype) * y) @ w_out


def nsa_mixer(x, w_in, gate_b, q_gain, kc_gain, ks_gain, kw_gain, pos_k, pos_v,
              ck_w1, ck_w2, cv_w1, cv_w2, w_out):
    B, S, _ = x.shape
    H, G, hpg, hd = NSA_HEADS, NSA_KV_GROUPS, NSA_HPG, NSA_HEAD_DIM
    l, d, ls, W, Qc = NSA_CMP_BLOCK, NSA_CMP_STRIDE, NSA_SEL_BLOCK, NSA_WINDOW, NSA_Q_CHUNK
    scale = hd ** -0.5
    n_cmp = (S - l) // d + 1
    n_slc = S // ls
    n_top = min(NSA_TOPN, n_slc)
    splits = [int(v) for v in np.cumsum([H * hd] + [NSA_KV_W] * 6)]
    q, kc, vc, ks, vs, kw, vw, g = jnp.split(x @ w_in, splits, axis=-1)
    q = rms_norm(q.reshape(B, S, G, hpg, hd), q_gain)
    gates = jax.nn.sigmoid(g + gate_b).reshape(B, S, G, hpg, NSA_N_BRANCH)
    cmp_idx = (jnp.arange(n_cmp) * d)[:, None] + jnp.arange(l)[None, :]

    def compress(t, pos_emb, w1, w2):
        blk = t.reshape(B, S, G, hd)[:, cmp_idx] + pos_emb[None, None, :, None, :]
        blk = blk.transpose(0, 1, 3, 2, 4).reshape(B, n_cmp, G, l * hd)
        return jax.nn.gelu(blk @ w1) @ w2

    k_cmp = rms_norm(compress(kc, pos_k, ck_w1, ck_w2), kc_gain)
    v_cmp = compress(vc, pos_v, cv_w1, cv_w2)
    cmp_end = jnp.arange(n_cmp) * d + l - 1
    c_start = jnp.arange(n_cmp) * d
    s_start = jnp.arange(n_slc) * ls
    overlap = ((c_start[:, None] < s_start[None, :] + ls)
               & (c_start[:, None] + l > s_start[None, :])).astype(F32)
    ks_blk = rms_norm(ks.reshape(B, S, G, hd), ks_gain).reshape(B, n_slc, ls, G, hd).transpose(0, 3, 1, 2, 4)
    vs_blk = vs.reshape(B, n_slc, ls, G, hd).transpose(0, 3, 1, 2, 4)
    wpad = ((0, 0), (W, 0), (0, 0), (0, 0))
    kw_pad = jnp.pad(rms_norm(kw.reshape(B, S, G, hd), kw_gain), wpad)
    vw_pad = jnp.pad(vw.reshape(B, S, G, hd), wpad)
    n_chunks = S // Qc
    q_chunks = q.reshape(B, n_chunks, Qc, G, hpg, hd).transpose(1, 0, 2, 3, 4, 5)
    g_chunks = gates.reshape(B, n_chunks, Qc, G, hpg, NSA_N_BRANCH).transpose(1, 0, 2, 3, 4, 5)
    b_ix = jnp.arange(B)[:, None, None, None]
    g_ix = jnp.arange(G)[None, :, None, None]
    blk_j = jnp.arange(n_slc)

    def attend_chunk(args):
        ci, qc, gc = args
        t0 = ci * Qc
        pos = t0 + jnp.arange(Qc)
        s_c = jnp.einsum('bqghd,bngd->bghqn', qc, k_cmp, preferred_element_type=F32) * scale
        m_c = cmp_end[None, :] <= pos[:, None]
        p_c = jnp.where(m_c, jax.nn.softmax(jnp.where(m_c, s_c, NEG), axis=-1), 0.0)
        o_c = jnp.einsum('bghqn,bngd->bqghd', p_c.astype(v_cmp.dtype), v_cmp)
        imp = jnp.einsum('bghqn,nj->bgqj', p_c, overlap)
        cur = (pos // ls)[:, None]
        forced = (blk_j[None, :] == 0) | ((cur - blk_j[None, :] >= 0) & (cur - blk_j[None, :] < NSA_LOCAL_BLOCKS))
        valid = (blk_j * ls)[None, :] <= pos[:, None]
        imp = jnp.where(valid, jnp.where(forced, FORCE, imp), NEG)
        _, sel = lax.top_k(imp, n_top)
        k_sel = ks_blk[b_ix, g_ix, sel]
        v_sel = vs_blk[b_ix, g_ix, sel]
        kpos = sel[..., None] * ls + jnp.arange(ls)
        m_s = (kpos <= pos[None, None, :, None, None])[:, :, None]
        s_s = jnp.einsum('bqghd,bgqnkd->bghqnk', qc, k_sel, preferred_element_type=F32) * scale
        s_s = jnp.where(m_s, s_s, NEG).reshape(B, G, hpg, Qc, n_top * ls)
        p_s = jax.nn.softmax(s_s, axis=-1).reshape(B, G, hpg, Qc, n_top, ls).astype(v_sel.dtype)
        o_s = jnp.einsum('bghqnk,bgqnkd->bqghd', p_s, v_sel)
        k_w = lax.dynamic_slice_in_dim(kw_pad, t0, W + Qc, axis=1)
        v_w = lax.dynamic_slice_in_dim(vw_pad, t0, W + Qc, axis=1)
        wpos = t0 - W + jnp.arange(W + Qc)
        m_w = ((wpos[None, :] <= pos[:, None]) & (wpos[None, :] > pos[:, None] - W) & (wpos[None, :] >= 0))
        s_w = jnp.einsum('bqghd,bkgd->bghqk', qc, k_w, preferred_element_type=F32) * scale
        p_w = jax.nn.softmax(jnp.where(m_w, s_w, NEG), axis=-1).astype(v_w.dtype)
        o_w = jnp.einsum('bghqk,bkgd->bqghd', p_w, v_w)
        return gc[..., 0:1] * o_c + gc[..., 1:2] * o_s + gc[..., 2:3] * o_w

    o = lax.map(attend_chunk, (jnp.arange(n_chunks), q_chunks, g_chunks))
    o = o.transpose(1, 0, 2, 3, 4, 5).reshape(B, S, H * hd)
    return o @ w_out


def _normal(k, shape, scale):
    return jax.random.normal(k, shape, F32) * scale


def setup_inputs(seed: int = 0) -> dict:
    key = jax.random.key(seed)
    ks = iter(jax.random.split(key, 40))
    D, F = D_MODEL, D_FF
    nA, nB, nC = N_LAYERS_A, N_LAYERS_B, N_LAYERS_C
    Wd, hdA, hdC = LRU_WIDTH, MOBA_HEAD_DIM, NSA_HEAD_DIM
    a0 = jax.random.uniform(next(ks), (nB, Wd), F32, minval=0.9, maxval=0.999)
    s = a0 ** (1.0 / LRU_C)
    return {
        "x": _normal(next(ks), (BATCH, SEQ, D), 1.0),
        "norm_g": 1.0 + _normal(next(ks), (DEPTH, 3, D), 0.01),
        "ffn1_wi": _normal(next(ks), (DEPTH, D, 2 * F), D ** -0.5),
        "ffn1_wo": _normal(next(ks), (DEPTH, F, D), F ** -0.5),
        "ffn2_wi": _normal(next(ks), (DEPTH, D, 2 * F), D ** -0.5),
        "ffn2_wo": _normal(next(ks), (DEPTH, F, D), F ** -0.5),
        "moba_w_in": _normal(next(ks), (nA, D, 3 * MOBA_HEADS * hdA), D ** -0.5),
        "moba_q_gain": 1.0 + _normal(next(ks), (nA, hdA), 0.01),
        "moba_k_gain": 1.0 + _normal(next(ks), (nA, hdA), 0.01),
        "moba_w_out": _normal(next(ks), (nA, MOBA_HEADS * hdA, D), (MOBA_HEADS * hdA) ** -0.5),
        "lru_w_in": _normal(next(ks), (nB, D, 2 * Wd), D ** -0.5),
        "lru_conv_w": _normal(next(ks), (nB, CONV_WIDTH, 1, Wd), CONV_WIDTH ** -0.5),
        "lru_conv_b": _normal(next(ks), (nB, Wd), 0.01),
        "lru_wa": _normal(next(ks), (nB, LRU_BLOCKS, LRU_BLOCK_W, LRU_BLOCK_W), LRU_BLOCK_W ** -0.5),
        "lru_ba": _normal(next(ks), (nB, Wd), 0.01),
        "lru_wx": _normal(next(ks), (nB, LRU_BLOCKS, LRU_BLOCK_W, LRU_BLOCK_W), LRU_BLOCK_W ** -0.5),
        "lru_bx": _normal(next(ks), (nB, Wd), 0.01),
        "lru_lam": jnp.log(s) - jnp.log1p(-s),
        "lru_w_out": _normal(next(ks), (nB, Wd, D), Wd ** -0.5),
        "nsa_w_in": _normal(next(ks), (nC, D, NSA_IN_WIDTH), D ** -0.5),
        "nsa_gate_b": _normal(next(ks), (nC, NSA_N_BRANCH * NSA_HEADS), 0.01),
        "nsa_q_gain": 1.0 + _normal(next(ks), (nC, hdC), 0.01),
        "nsa_kc_gain": 1.0 + _normal(next(ks), (nC, hdC), 0.01),
        "nsa_ks_gain": 1.0 + _normal(next(ks), (nC, hdC), 0.01),
        "nsa_kw_gain": 1.0 + _normal(next(ks), (nC, hdC), 0.01),
        "nsa_pos_k": _normal(next(ks), (nC, NSA_CMP_BLOCK, hdC), 0.1),
        "nsa_pos_v": _normal(next(ks), (nC, NSA_CMP_BLOCK, hdC), 0.1),
        "nsa_ck_w1": _normal(next(ks), (nC, NSA_CMP_BLOCK * hdC, NSA_CMP_HIDDEN), (NSA_CMP_BLOCK * hdC) ** -0.5),
        "nsa_ck_w2": _normal(next(ks), (nC, NSA_CMP_HIDDEN, hdC), NSA_CMP_HIDDEN ** -0.5),
        "nsa_cv_w1": _normal(next(ks), (nC, NSA_CMP_BLOCK * hdC, NSA_CMP_HIDDEN), (NSA_CMP_BLOCK * hdC) ** -0.5),
        "nsa_cv_w2": _normal(next(ks), (nC, NSA_CMP_HIDDEN, hdC), NSA_CMP_HIDDEN ** -0.5),
        "nsa_w_out": _normal(next(ks), (nC, NSA_HEADS * hdC, D), (NSA_HEADS * hdC) ** -0.5),
    }


def reference(x, norm_g, ffn1_wi, ffn1_wo, ffn2_wi, ffn2_wo,
              moba_w_in, moba_q_gain, moba_k_gain, moba_w_out,
              lru_w_in, lru_conv_w, lru_conv_b, lru_wa, lru_ba, lru_wx, lru_bx, lru_lam, lru_w_out,
              nsa_w_in, nsa_gate_b, nsa_q_gain, nsa_kc_gain, nsa_ks_gain, nsa_kw_gain,
              nsa_pos_k, nsa_pos_v, nsa_ck_w1, nsa_ck_w2, nsa_cv_w1, nsa_cv_w2, nsa_w_out):
    h = x
    for i in range(DEPTH):
        j = i // N_MIXERS
        kind = i % N_MIXERS
        h = h + FFN_RESID * swiglu_ffn(rms_norm(h, norm_g[i, 0]), ffn1_wi[i], ffn1_wo[i])
        u = rms_norm(h, norm_g[i, 1])
        if kind == 0:
            m = moba_mixer(u, moba_w_in[j], moba_q_gain[j], moba_k_gain[j], moba_w_out[j])
        elif kind == 1:
            m = rglru_mixer(u, lru_w_in[j], lru_conv_w[j], lru_conv_b[j], lru_wa[j], lru_ba[j],
                            lru_wx[j], lru_bx[j], lru_lam[j], lru_w_out[j])
        else:
            m = nsa_mixer(u, nsa_w_in[j], nsa_gate_b[j], nsa_q_gain[j], nsa_kc_gain[j], nsa_ks_gain[j],
                          nsa_kw_gain[j], nsa_pos_k[j], nsa_pos_v[j], nsa_ck_w1[j], nsa_ck_w2[j],
                          nsa_cv_w1[j], nsa_cv_w2[j], nsa_w_out[j])
        h = h + m
        h = h + FFN_RESID * swiglu_ffn(rms_norm(h, norm_g[i, 2]), ffn2_wi[i], ffn2_wo[i])
    return h
```

```cpp
#include <hip/hip_runtime.h>
#include <hip/hip_cooperative_groups.h>
#include <stdint.h>
#include <cstdio>
namespace cg = cooperative_groups;

typedef unsigned short u16;
typedef short bf16x8 __attribute__((ext_vector_type(8)));
typedef short s16x4 __attribute__((ext_vector_type(4)));
typedef float f32x4 __attribute__((ext_vector_type(4)));
typedef float f32x16 __attribute__((ext_vector_type(16)));
#define DI __device__ __forceinline__

constexpr int T_ = 16384, S_ = 4096, D_ = 1024, F_ = 2816;
constexpr float EPS_ = 1e-6f;
constexpr float LOG2E = 1.4426950408889634f;

#ifndef PROBE_DUP
#define PROBE_DUP 0
#endif
#ifndef MEGA
#define MEGA 1
#endif

constexpr size_t MB = 1024 * 1024;
constexpr size_t WT_BYTES = 48 * MB;
constexpr size_t OFF_HB = 96 * MB;
constexpr size_t OFF_SSQ = 128 * MB;
constexpr size_t OFF_PC = 44 * MB;
constexpr size_t OFF_HC = 46 * MB;
constexpr size_t OFF_SCR = 134 * MB;
constexpr size_t SSQ_STRIDE = (size_t)T_ * 4;
constexpr size_t W_UP1 = 0, W_DN1 = W_UP1 + 5632 * 1024, W_UP2 = W_DN1 + 1024 * 2816, W_DN2 = W_UP2 + 5632 * 1024,
                 W_MIN = W_DN2 + 1024 * 2816, W_MOUT = W_MIN + 3072 * 1024, W_EXT = W_MOUT + 1024 * 1024;
constexpr size_t A_RAW = 0, A_KN = 104 * MB, A_VT = 136 * MB, A_O = 224 * MB, A_KMEAN = 200 * MB;
constexpr size_t L_RAW = 0, L_XC = 64 * MB, L_A = 96 * MB, L_B = 160 * MB, L_HY = 224 * MB;
constexpr size_t N_RAW = 0, N_KSN = 96 * MB, N_KWN = 104 * MB, N_VST = 112 * MB, N_VWT = 120 * MB, N_AK = 128 * MB,
                 N_AV = 144 * MB, N_HK = 162 * MB, N_HV = 164 * MB, N_KCMP = 166 * MB, N_VCMPT = 167 * MB, N_GATES = 168 * MB,
                 N_O = 224 * MB;

enum { OP_INIT = 0, OP_UP1, OP_DN1, OP_IN, OP_M1, OP_M2, OP_M3, OP_M4, OP_OUT, OP_UP2, OP_DN2 };

struct Params {
  const float* in[32];
  float* out;
  char* ws;
  int nprog;
  int pad0;
  unsigned char prog[64];
};

typedef __bf16 bf16x2_t __attribute__((ext_vector_type(2)));
typedef float f32x2_t __attribute__((ext_vector_type(2)));
DI unsigned pack2(float a, float b) { f32x2_t f = {a, b}; bf16x2_t h = __builtin_convertvector(f, bf16x2_t); return __builtin_bit_cast(unsigned, h); }
DI u16 f2bf(float x) { return (u16)(pack2(x, 0.f) & 0xffffu); }
DI float bf2f(u16 v) { return __uint_as_float(((unsigned)v) << 16); }
DI float gelu_t(float x) { float u = 1.5957691216057308f * (x + 0.044715f * x * x * x); return x * __builtin_amdgcn_rcpf(1.f + __expf(-u)); }
DI float sigmoidf(float x) { return __builtin_amdgcn_rcpf(1.f + __expf(-x)); }
DI int bidx() { int t = blockIdx.x; asm volatile("" : "+s"(t)); return t; }
DI int gdim() { int t = gridDim.x; asm volatile("" : "+s"(t)); return t; }
DI int tidx() { int t = threadIdx.x; asm volatile("" : "+v"(t)); return t; }

DI void conv_job(const float* src, const float* src2, int ld, int K, int R, int nvalid, int kind, const float* g, u16* dst, char* shm, int vbid, int vnb) {
  float* tile = (float*)shm;
  const int ntk = K / 64, ntr = R / 64, tid = tidx();
  for (int t = vbid; t < ntr * ntk; t += vnb) {
    const int tr = t / ntk, tk = t % ntk, r0 = tr * 64, k0 = tk * 64;
    const float* sp = src; int col0 = r0, nv = nvalid - r0, sld = ld;
    if (kind == 1) { int tile256 = r0 >> 8, within = r0 & 255, half = within >> 7, c = within & 127; col0 = half * 2816 + tile256 * 128 + c; nv = 64; }
    else if (kind == 2) { int pn = r0 >> 8, within = r0 & 255, half = within >> 7, c = within & 127; sp = (half ? src2 : src) + (size_t)(pn >> 1) * 65536; col0 = (pn & 1) * 128 + c; nv = 64; sld = 256; }
    {
      const int kk = tid >> 4, c4 = (tid & 15) * 4;
#pragma unroll
      for (int ps = 0; ps < 2; ++ps) {
        const int k = kk + ps * 32;
        float4 v = make_float4(0.f, 0.f, 0.f, 0.f);
        if (c4 < nv) v = *(const float4*)(sp + (size_t)(k0 + k) * sld + col0 + c4);
        const float gg = g ? g[k0 + k] : 1.f;
        tile[k * 65 + c4 + 0] = v.x * gg; tile[k * 65 + c4 + 1] = v.y * gg; tile[k * 65 + c4 + 2] = v.z * gg; tile[k * 65 + c4 + 3] = v.w * gg;
      }
    }
    __syncthreads();
    {
      const int n = tid >> 3, ks = (tid & 7) * 8;
      uint4 w;
      w.x = pack2(tile[(ks + 0) * 65 + n], tile[(ks + 1) * 65 + n]);
      w.y = pack2(tile[(ks + 2) * 65 + n], tile[(ks + 3) * 65 + n]);
      w.z = pack2(tile[(ks + 4) * 65 + n], tile[(ks + 5) * 65 + n]);
      w.w = pack2(tile[(ks + 6) * 65 + n], tile[(ks + 7) * 65 + n]);
      *(uint4*)(dst + (size_t)(r0 + n) * K + k0 + ks) = w;
    }
    __syncthreads();
  }
}

DI void convert_layer(const Params& p, int L, char* shm, int vbid, int vnb, int mask) {
  if (L >= 4) return;
  const int kind = L % 3, j = L / 3;
  u16* WT = (u16*)(p.ws + (size_t)(L & 1) * WT_BYTES);
  const float* ng = p.in[1] + (size_t)L * 3 * 1024;
  if (mask & 1) conv_job(p.in[2] + (size_t)L * 1024 * 5632, nullptr, 5632, 1024, 5632, 5632, 1, ng, WT + W_UP1, shm, vbid, vnb);
  if (!(mask & 2)) return;
  conv_job(p.in[3] + (size_t)L * 2816 * 1024, nullptr, 1024, 2816, 1024, 1024, 0, nullptr, WT + W_DN1, shm, vbid, vnb);
  conv_job(p.in[4] + (size_t)L * 1024 * 5632, nullptr, 5632, 1024, 5632, 5632, 1, ng + 2048, WT + W_UP2, shm, vbid, vnb);
  conv_job(p.in[5] + (size_t)L * 2816 * 1024, nullptr, 1024, 2816, 1024, 1024, 0, nullptr, WT + W_DN2, shm, vbid, vnb);
  if (kind == 0) {
    conv_job(p.in[6] + (size_t)j * 1024 * 3072, nullptr, 3072, 1024, 3072, 3072, 0, ng + 1024, WT + W_MIN, shm, vbid, vnb);
    conv_job(p.in[9] + (size_t)j * 1024 * 1024, nullptr, 1024, 1024, 1024, 1024, 0, nullptr, WT + W_MOUT, shm, vbid, vnb);
  } else if (kind == 1) {
    conv_job(p.in[10], nullptr, 2048, 1024, 2048, 2048, 0, ng + 1024, WT + W_MIN, shm, vbid, vnb);
    conv_job(p.in[18], nullptr, 1024, 1024, 1024, 1024, 0, nullptr, WT + W_MOUT, shm, vbid, vnb);
    conv_job(p.in[13], p.in[15], 256, 256, 2048, 2048, 2, nullptr, WT + W_EXT, shm, vbid, vnb);
  } else {
    conv_job(p.in[19], nullptr, 2608, 1024, 2816, 2608, 0, ng + 1024, WT + W_MIN, shm, vbid, vnb);
    conv_job(p.in[31], nullptr, 1024, 1024, 1024, 1024, 0, nullptr, WT + W_MOUT, shm, vbid, vnb);
    conv_job(p.in[27], nullptr, 256, 2048, 256, 256, 0, nullptr, WT + W_EXT, shm, vbid, vnb);
    conv_job(p.in[29], nullptr, 256, 2048, 256, 256, 0, nullptr, WT + W_EXT + 256 * 2048, shm, vbid, vnb);
  }
}
DI void convert_on_idle(const Params& p, int L, char* shm, int ntiles, int mask) {
  const int nb = (int)gridDim.x, bid = (int)blockIdx.x;
  const int rem = __builtin_amdgcn_readfirstlane(ntiles % nb);
  if (rem == 0) convert_layer(p, L, shm, bid, nb, mask);
  else if (bid >= rem) convert_layer(p, L, shm, bid - rem, nb - rem, mask);
}

constexpr int STG_LD = 260;
constexpr int BM = 256, BK = 64, HALF = 128, NXCD = 8, WGM = 8, HT = HALF * BK, SHM_B = 8 * HT * 2;

DI int lds_byte(int r, int c) {
  int st = (r >> 4) * 2 + (c >> 5), rr = r & 15, cc = c & 31, ob = rr * 64 + cc * 2;
  return st * 1024 + (ob ^ (((ob >> 9) & 1) << 5));
}
DI void stage_rc(int b, int& R, int& C) {
  int st = b / 1024, sb = b % 1024, swz = sb ^ (((sb >> 9) & 1) << 5);
  R = (st >> 1) * 16 + swz / 64; C = (st & 1) * 32 + (swz % 64) / 2;
}

DI void glds16(const void* sbase, unsigned voff, unsigned lds_addr) {
  unsigned keep;
  asm volatile("s_mov_b32 %0, m0\n\ts_mov_b32 m0, %3\n\ts_nop 0\n\tglobal_load_lds_dwordx4 %1, %2\n\ts_mov_b32 m0, %0"
               : "=&s"(keep) : "v"(voff), "s"(sbase), "s"(lds_addr) : "memory");
}
struct GemmArgs { const u16* A; int lda; const u16* Bt; int ldb; int M, N, K; int a_pn_shift; int b_pm_shift; int splitk; };

template <class Epi>
DI void gemm_phase(const GemmArgs& g, const Epi& epi, char* shmc) {
  u16* shm = (u16*)shmc;
  const int tid_ = tidx();
  const int lda = g.lda, ldb = g.ldb, K = g.K;
#define SA(b, h) (shm + ((b)*4 + (h)) * HT)
#define SB(b, h) (shm + ((b)*4 + 2 + (h)) * HT)
#define STAGE(P, BASE, LD, br, kt)                                                                                  \
  do {                                                                                                              \
    const u16* _ub = (BASE) + ((long)(br) * (LD) + (long)(kt)*BK);                                                  \
    const unsigned _la = lds0 + (unsigned)((char*)(P) - shmc);     \
    glds16(_ub, so_##LD[0], _la);                                                                                   \
    glds16(_ub, so_##LD[1], _la + 8192u);                                                                           \
  } while (0)
#define LDA(dst, b, h)                                                                                              \
  for (int m = 0; m < 4; ++m) for (int k = 0; k < 2; ++k)                                                           \
    dst[m][k] = *reinterpret_cast<const bf16x8*>((char*)SA(b, h) + lds_byte(wr * 64 + m * 16 + fr, k * 32 + fq * 8))
#define LDB(dst, b, h)                                                                                              \
  for (int n = 0; n < 2; ++n) for (int k = 0; k < 2; ++k)                                                           \
    dst[n][k] = *reinterpret_cast<const bf16x8*>((char*)SB(b, h) + lds_byte(wc * 32 + n * 16 + fr, k * 32 + fq * 8))
#define MMA(ai, bj, At_, Bt_)                                                                                       \
  do {                                                                                                              \
    __builtin_amdgcn_s_setprio(1);                                                                                  \
    for (int m = 0; m < 4; ++m) for (int n = 0; n < 2; ++n) for (int k = 0; k < 2; ++k)                             \
      acc[ai][bj][m][n] = __builtin_amdgcn_mfma_f32_16x16x32_bf16(Bt_[n][k], At_[m][k], acc[ai][bj][m][n], 0, 0, 0); \
    __builtin_amdgcn_s_setprio(0);                                                                                  \
  } while (0)
#define WAIT_V(n) asm volatile("s_waitcnt vmcnt(" #n ")" ::: "memory")
#define WAIT_L(n) asm volatile("s_waitcnt lgkmcnt(" #n ")" ::: "memory")
#define BAR __builtin_amdgcn_s_barrier()
#define SCHED __builtin_amdgcn_sched_barrier(0)

  const int nM = g.M / BM, nN = g.N / BM, nwg = nM * nN;
  const int wid = tid_ >> 6, lane = tid_ & 63, wr = wid >> 2, wc = wid & 3, fr = lane & 15, fq = lane >> 4;
  int nt = K / BK;
  asm volatile("" : "+s"(nt));
  const unsigned lds0 = (unsigned)__builtin_amdgcn_readfirstlane((int)((unsigned)(size_t)(__attribute__((address_space(3))) char*)shmc + (unsigned)(tid_ & ~63) * 16u));
  unsigned so_lda[2], so_ldb[2];
  for (int _i = 0; _i < 2; ++_i) { int _r, _c; stage_rc(tid_ * 16 + _i * 8192, _r, _c); so_lda[_i] = (unsigned)(_r * lda + _c) * 2u; so_ldb[_i] = (unsigned)(_r * ldb + _c) * 2u; }
#define TILE_COORDS(tile_, pm_, pn_)                                                                               \
  do {                                                                                                              \
    int wgid = (tile_);                                                                                             \
    { int q = nwg / NXCD, r = nwg % NXCD, xcd = wgid % NXCD, off = wgid / NXCD; wgid = (xcd < r ? xcd * (q + 1) : r * (q + 1) + (xcd - r) * q) + off; } \
    int nig = WGM * nN, gid = wgid / nig, fm = gid * WGM, gsz = min(nM - fm, WGM);                                  \
    pm_ = fm + ((wgid % nig) % gsz); pn_ = (wgid % nig) / gsz;                                                      \
  } while (0)
#define FIRST_STAGES(pm_, pn_)                                                                                      \
  do {                                                                                                              \
    const u16* A_ = g.A + (g.a_pn_shift >= 0 ? (size_t)((pn_) >> g.a_pn_shift) * K : 0);                            \
    const u16* Bt_ = g.Bt + (g.b_pm_shift >= 0 ? (size_t)((pm_) >> g.b_pm_shift) * ((size_t)g.N * K) : 0) + (g.splitk ? (size_t)(pn_) * K : 0); \
    const int bcB_ = g.splitk ? 0 : (pn_)*BM;                                                                        \
    STAGE(SB(0, 0), Bt_, ldb, bcB_, 0); STAGE(SA(0, 0), A_, lda, (pm_)*BM, 0);                                      \
    STAGE(SB(0, 1), Bt_, ldb, bcB_ + HALF, 0); STAGE(SA(0, 1), A_, lda, (pm_)*BM + HALF, 0);                        \
  } while (0)
  const int gstep = gdim();
  int tile = bidx(), pm = 0, pn = 0;
  if (tile < nwg) { TILE_COORDS(tile, pm, pn); FIRST_STAGES(pm, pn); }
  while (tile < nwg) {
    const int brow = pm * BM, bcol = pn * BM;
    const u16* __restrict__ A = g.A + (g.a_pn_shift >= 0 ? (size_t)(pn >> g.a_pn_shift) * K : 0);
    const u16* __restrict__ Bt = g.Bt + (g.b_pm_shift >= 0 ? (size_t)(pm >> g.b_pm_shift) * ((size_t)g.N * K) : 0) + (g.splitk ? (size_t)pn * K : 0);
    const int bcolB = g.splitk ? 0 : bcol;
    f32x4 acc[2][2][4][2] = {};
    bf16x8 At[4][2], B0[2][2], B1[2][2];
    if (wr == 1) BAR;
    WAIT_V(4); BAR;
    STAGE(SB(1, 0), Bt, ldb, bcolB, 1); STAGE(SA(1, 0), A, lda, brow, 1); STAGE(SB(1, 1), Bt, ldb, bcolB + HALF, 1);
    WAIT_V(6); BAR;
    for (int t = 0; t < nt - 2; t += 2) {
      LDB(B0, 0, 0); SCHED; LDA(At, 0, 0); STAGE(SA(1, 1), A, lda, brow + HALF, t + 1);
      WAIT_L(8); BAR; WAIT_L(0); MMA(0, 0, At, B0); BAR; SCHED;
      LDB(B1, 0, 1); STAGE(SB(0, 0), Bt, ldb, bcolB, t + 2);
      BAR; WAIT_L(0); MMA(0, 1, At, B1); BAR;
      LDA(At, 0, 1); STAGE(SA(0, 0), A, lda, brow, t + 2);
      BAR; WAIT_L(0); MMA(1, 0, At, B0); BAR; SCHED;
      STAGE(SB(0, 1), Bt, ldb, bcolB + HALF, t + 2);
      WAIT_V(6); BAR; MMA(1, 1, At, B1); BAR;
      LDB(B0, 1, 0); SCHED; LDA(At, 1, 0); STAGE(SA(0, 1), A, lda, brow + HALF, t + 2);
      WAIT_L(8); BAR; WAIT_L(0); MMA(0, 0, At, B0); BAR; SCHED;
      LDB(B1, 1, 1); STAGE(SB(1, 0), Bt, ldb, bcolB, t + 3);
      BAR; WAIT_L(0); MMA(0, 1, At, B1); BAR;
      LDA(At, 1, 1); STAGE(SA(1, 0), A, lda, brow, t + 3);
      BAR; WAIT_L(0); MMA(1, 0, At, B0); BAR; SCHED;
      STAGE(SB(1, 1), Bt, ldb, bcolB + HALF, t + 3);
      WAIT_V(6); BAR; MMA(1, 1, At, B1); BAR;
    }
    { LDB(B0, 0, 0); LDA(At, 0, 0); STAGE(SA(1, 1), A, lda, brow + HALF, nt - 1);
      BAR; WAIT_L(0); MMA(0, 0, At, B0); BAR;
      LDB(B1, 0, 1); BAR; WAIT_L(0); MMA(0, 1, At, B1); BAR;
      LDA(At, 0, 1); WAIT_V(4); BAR; WAIT_L(0); MMA(1, 0, At, B0); MMA(1, 1, At, B1); BAR; }
    { LDB(B0, 1, 0); LDA(At, 1, 0); WAIT_V(2); BAR; WAIT_L(0); MMA(0, 0, At, B0); BAR;
      LDB(B1, 1, 1); WAIT_V(0); BAR; WAIT_L(0); MMA(0, 1, At, B1); BAR;
      LDA(At, 1, 1); BAR; WAIT_L(0); MMA(1, 0, At, B0); MMA(1, 1, At, B1); BAR; }
    if (wr == 0) BAR;
    const int ntile = tile + gstep; int npm = 0, npn = 0;
    if (ntile < nwg) { TILE_COORDS(ntile, npm, npn); FIRST_STAGES(npm, npn); }
    {
      int t2 = threadIdx.x;
      asm volatile("" : "+v"(t2));
      const int wid2 = t2 >> 6, lane2 = t2 & 63, wr2 = wid2 >> 2, wc2 = wid2 & 3, fr2 = lane2 & 15, fq2 = lane2 >> 4;
      if constexpr (Epi::REGMODE) {
        epi.reg(acc, shmc + 65536, brow, pn, t2);
      } else {
      float* stg = (float*)(shmc + 65536);
      typename Epi::Pre pre[2];
      epi.pre(pre[0], brow, pn, wid2, lane2);
#pragma unroll
      for (int q = 0; q < 4; ++q) {
        if (q > 0) __syncthreads();
        if (wr2 == (q & 1)) {
#pragma unroll
          for (int m = 0; m < 4; ++m)
#pragma unroll
            for (int bj = 0; bj < 2; ++bj)
#pragma unroll
              for (int n = 0; n < 2; ++n)
                *(f32x4*)(stg + (m * 16 + fr2) * STG_LD + bj * 128 + wc2 * 32 + n * 16 + fq2 * 4) = acc[q >> 1][bj][m][n];
        }
        __syncthreads();
        if (q < 3) epi.pre(pre[(q + 1) & 1], brow + (q + 1) * 64, pn, wid2, lane2);
        epi(pre[q & 1], stg, brow + q * 64, pn, wid2, lane2);
      }
      }
    }
    __syncthreads();
    tile = ntile; pm = npm; pn = npn;
  }
#undef TILE_COORDS
#undef FIRST_STAGES
#undef SA
#undef SB
#undef STAGE
#undef LDA
#undef LDB
#undef MMA
}

typedef f32x4 AccT[2][2][4][2];
DI float row_rstd(const float* ssq, int row) {
  const f32x4 a = *(const f32x4*)(ssq + (size_t)row * 4);
  return rsqrtf(((a[0] + a[1]) + (a[2] + a[3])) * (1.f / 1024.f) + EPS_);
}
struct EpiStore {
  u16* O; int ldc; const float* ssq; int gelu_from;
  static constexpr bool REGMODE = true;
  DI void reg(const AccT& acc, char* lds, int brow, int pn, int t2) const {
    const int wid = t2 >> 6, lane = t2 & 63, wr = wid >> 2, wc = wid & 3, fr = lane & 15, fq = lane >> 4;
    u16* st = (u16*)lds;
    const bool dog = (pn * 256 >= gelu_from);
#pragma unroll
    for (int ai = 0; ai < 2; ++ai) {
      if (ai == 1) __syncthreads();
      f32x4 pq[4];
      if (ssq) {
#pragma unroll
        for (int m = 0; m < 4; ++m) pq[m] = *(const f32x4*)(ssq + (size_t)(brow + ai * 128 + wr * 64 + m * 16 + fr) * 4);
      }
#pragma unroll
      for (int m = 0; m < 4; ++m) {
        const int rl = wr * 64 + m * 16 + fr;
        const float rs = ssq ? rsqrtf(((pq[m][0] + pq[m][1]) + (pq[m][2] + pq[m][3])) * (1.f / 1024.f) + EPS_) : 1.f;
#pragma unroll
        for (int bj = 0; bj < 2; ++bj)
#pragma unroll
          for (int n = 0; n < 2; ++n) {
            f32x4 v = acc[ai][bj][m][n] * rs;
            if (dog) { v[0] = gelu_t(v[0]); v[1] = gelu_t(v[1]); v[2] = gelu_t(v[2]); v[3] = gelu_t(v[3]); }
            uint2 w; w.x = pack2(v[0], v[1]); w.y = pack2(v[2], v[3]);
            *(uint2*)(st + rl * 264 + bj * 128 + wc * 32 + n * 16 + fq * 4) = w;
          }
      }
      __syncthreads();
#pragma unroll
      for (int i = 0; i < 8; ++i) {
        const int c = t2 + 512 * i, row = c >> 5, seg = c & 31;
        const uint4 w = *(const uint4*)(st + row * 264 + seg * 8);
        *(uint4*)(O + (size_t)(brow + ai * 128 + row) * ldc + pn * 256 + seg * 8) = w;
      }
    }
  }
  struct Pre {};
  DI void pre(Pre&, int, int, int, int) const {}
  DI void operator()(const Pre&, const float* stg, int brow, int pn, int wv, int lane) const {
    const bool dog = (pn * 256 >= gelu_from);
#pragma unroll 4
    for (int rr = wv; rr < 64; rr += 8) {
      const int row = brow + rr;
      const float rs = ssq ? row_rstd(ssq, row) : 1.f;
      f32x4 v = *(const f32x4*)(stg + rr * STG_LD + lane * 4) * rs;
      if (dog) { v[0] = gelu_t(v[0]); v[1] = gelu_t(v[1]); v[2] = gelu_t(v[2]); v[3] = gelu_t(v[3]); }
      uint2 w; w.x = pack2(v[0], v[1]); w.y = pack2(v[2], v[3]);
      *(uint2*)(O + (size_t)row * ldc + pn * 256 + lane * 4) = w;
    }
  }
};

struct EpiMobaIn {
  u16* RAW; const float* ssq; const float* kgain; u16* KN; u16* VT; float* KMEAN;
  static constexpr bool REGMODE = true;
  struct Pre {};
  DI void pre(Pre&, int, int, int, int) const {}
  DI void operator()(const Pre&, const float*, int, int, int, int) const {}
  DI void reg(const AccT& acc, char* lds, int brow, int pn, int t2) const {
    const int wid = t2 >> 6, lane = t2 & 63, wr = wid >> 2, wc = wid & 3, fr = lane & 15, fq = lane >> 4;
    u16* st = (u16*)lds;
    float* red = (float*)(lds + 67584);
    const int b = brow >> 12, tloc = brow & (S_ - 1), nblk = tloc >> 8;
    float ksum = 0.f;
#pragma unroll
    for (int ai = 0; ai < 2; ++ai) {
      if (ai == 1) __syncthreads();
      f32x4 pq[4];
#pragma unroll
      for (int m = 0; m < 4; ++m) pq[m] = *(const f32x4*)(ssq + (size_t)(brow + ai * 128 + wr * 64 + m * 16 + fr) * 4);
#pragma unroll
      for (int m = 0; m < 4; ++m) {
        const int rl = wr * 64 + m * 16 + fr;
        const float rs = rsqrtf(((pq[m][0] + pq[m][1]) + (pq[m][2] + pq[m][3])) * (1.f / 1024.f) + EPS_);
#pragma unroll
        for (int bj = 0; bj < 2; ++bj)
#pragma unroll
          for (int n = 0; n < 2; ++n) {
            const f32x4 v = acc[ai][bj][m][n] * rs;
            uint2 w; w.x = pack2(v[0], v[1]); w.y = pack2(v[2], v[3]);
            *(uint2*)(st + rl * 264 + bj * 128 + wc * 32 + n * 16 + fq * 4) = w;
          }
      }
      __syncthreads();
      if (pn < 4) {
#pragma unroll
        for (int i = 0; i < 8; ++i) {
          const int c = t2 + 512 * i, row = c >> 5, seg = c & 31;
          const uint4 w = *(const uint4*)(st + row * 264 + seg * 8);
          *(uint4*)(RAW + (size_t)(brow + ai * 128 + row) * 3072 + pn * 256 + seg * 8) = w;
        }
      } else if (pn < 8) {
        const int seg = t2 & 31, d0 = (seg & 7) * 8;
        float gn[8], cs[8];
#pragma unroll
        for (int j = 0; j < 8; ++j) { gn[j] = kgain[d0 + j]; cs[j] = 0.f; }
#pragma unroll
        for (int i = 0; i < 8; ++i) {
          const int row = (t2 >> 5) + 16 * i;
          const uint4 w = *(const uint4*)(st + row * 264 + seg * 8);
          const unsigned uu[4] = {w.x, w.y, w.z, w.w};
          float v[8]; float ss = 0.f;
#pragma unroll
          for (int q = 0; q < 4; ++q) { v[2 * q] = bf2f((u16)(uu[q] & 0xffff)); v[2 * q + 1] = bf2f((u16)(uu[q] >> 16)); }
#pragma unroll
          for (int j = 0; j < 8; ++j) ss += v[j] * v[j];
          ss += __shfl_xor(ss, 1); ss += __shfl_xor(ss, 2); ss += __shfl_xor(ss, 4);
          const float r2 = rsqrtf(ss * (1.f / 64.f) + EPS_);
#pragma unroll
          for (int j = 0; j < 8; ++j) { v[j] = v[j] * r2 * gn[j]; cs[j] += v[j]; }
          uint4 o4; o4.x = pack2(v[0], v[1]); o4.y = pack2(v[2], v[3]); o4.z = pack2(v[4], v[5]); o4.w = pack2(v[6], v[7]);
          *(uint4*)(KN + (size_t)(brow + ai * 128 + row) * 1024 + (pn - 4) * 256 + seg * 8) = o4;
        }
#pragma unroll
        for (int j = 0; j < 8; ++j) cs[j] += __shfl_xor(cs[j], 32);
        if (lane < 32) {
#pragma unroll
          for (int j = 0; j < 8; ++j) red[wid * 256 + seg * 8 + j] = cs[j];
        }
        __syncthreads();
        if (t2 < 256) { float sm = 0.f;
#pragma unroll
          for (int w8 = 0; w8 < 8; ++w8) sm += red[w8 * 256 + t2];
          ksum += sm; }
      } else {
#pragma unroll
        for (int i = 0; i < 8; ++i) {
          const int item = t2 + 512 * i, rg = item & 15, col = item >> 4;
          unsigned uu[4];
#pragma unroll
          for (int q = 0; q < 4; ++q) uu[q] = (unsigned)st[(rg * 8 + 2 * q) * 264 + col] | ((unsigned)st[(rg * 8 + 2 * q + 1) * 264 + col] << 16);
          uint4 o4; o4.x = uu[0]; o4.y = uu[1]; o4.z = uu[2]; o4.w = uu[3];
          *(uint4*)(VT + (size_t)(b * 1024 + (pn - 8) * 256 + col) * S_ + tloc + ai * 128 + rg * 8) = o4;
        }
      }
    }
    if (pn >= 4 && pn < 8 && t2 < 256) KMEAN[((size_t)(b * 16 + (pn - 4) * 4 + (t2 >> 6)) * 16 + nblk) * 64 + (t2 & 63)] = ksum * (1.f / 256.f);
  }
};

struct EpiPartial {
  float* P; int M;
  static constexpr bool REGMODE = true;
  struct Pre {};
  DI void pre(Pre&, int, int, int, int) const {}
  DI void operator()(const Pre&, const float*, int, int, int, int) const {}
  DI void reg(const AccT& acc, char* lds, int brow, int pn, int t2) const {
    const int wid = t2 >> 6, lane = t2 & 63, wr = wid >> 2, wc = wid & 3, fr = lane & 15, fq = lane >> 4;
#pragma unroll
    for (int ai = 0; ai < 2; ++ai)
#pragma unroll
      for (int m = 0; m < 4; ++m) {
        float* rowp = P + ((size_t)pn * M + brow + ai * 128 + wr * 64 + m * 16 + fr) * 256;
#pragma unroll
        for (int bj = 0; bj < 2; ++bj)
#pragma unroll
          for (int n = 0; n < 2; ++n) *(f32x4*)(rowp + bj * 128 + wc * 32 + n * 16 + fq * 4) = acc[ai][bj][m][n];
      }
  }
};

struct EpiSwiglu {
  u16* O; const float* ssq;
  static constexpr bool REGMODE = true;
  DI void reg(const AccT& acc, char* lds, int brow, int pn, int t2) const {
    const int wid = t2 >> 6, lane = t2 & 63, wr = wid >> 2, wc = wid & 3, fr = lane & 15, fq = lane >> 4;
    u16* st = (u16*)lds;
    f32x4 pq[8];
#pragma unroll
    for (int q = 0; q < 8; ++q) pq[q] = *(const f32x4*)(ssq + (size_t)(brow + (q >> 2) * 128 + wr * 64 + (q & 3) * 16 + fr) * 4);
#pragma unroll
    for (int ai = 0; ai < 2; ++ai)
#pragma unroll
      for (int m = 0; m < 4; ++m) {
        const int rl = ai * 128 + wr * 64 + m * 16 + fr;
        const f32x4 q4 = pq[ai * 4 + m];
        const float rs = rsqrtf(((q4[0] + q4[1]) + (q4[2] + q4[3])) * (1.f / 1024.f) + EPS_);
#pragma unroll
        for (int n = 0; n < 2; ++n) {
          const f32x4 gt = acc[ai][0][m][n] * rs, up = acc[ai][1][m][n] * rs;
          f32x4 v;
#pragma unroll
          for (int j = 0; j < 4; ++j) v[j] = gt[j] * sigmoidf(gt[j]) * up[j];
          uint2 w; w.x = pack2(v[0], v[1]); w.y = pack2(v[2], v[3]);
          *(uint2*)(st + rl * 136 + wc * 32 + n * 16 + fq * 4) = w;
        }
      }
    __syncthreads();
#pragma unroll
    for (int i = 0; i < 8; ++i) {
      const int c = t2 + 512 * i, row = c >> 4, seg = c & 15;
      const uint4 w = *(const uint4*)(st + row * 136 + seg * 8);
      *(uint4*)(O + (size_t)(brow + row) * F_ + pn * 128 + seg * 8) = w;
    }
  }
  struct Pre {};
  DI void pre(Pre&, int, int, int, int) const {}
  DI void operator()(const Pre&, const float* stg, int brow, int pn, int wv, int lane) const {
    const int l32 = lane & 31;
#pragma unroll 4
    for (int rp = wv; rp < 32; rp += 8) {
      const int rr = rp * 2 + (lane >> 5), row = brow + rr;
      const float rs = row_rstd(ssq, row);
      const f32x4 gt = *(const f32x4*)(stg + rr * STG_LD + l32 * 4) * rs, up = *(const f32x4*)(stg + rr * STG_LD + 128 + l32 * 4) * rs;
      f32x4 v;
#pragma unroll
      for (int j = 0; j < 4; ++j) v[j] = gt[j] * sigmoidf(gt[j]) * up[j];
      uint2 w; w.x = pack2(v[0], v[1]); w.y = pack2(v[2], v[3]);
      *(uint2*)(O + (size_t)row * F_ + pn * 128 + l32 * 4) = w;
    }
  }
};

struct EpiResid {
  static constexpr bool REGMODE = false;
  DI void reg(const AccT&, char*, int, int, int) const {}
  float* fout; u16* hb; float* ssq_next; float scale;
  struct Pre { uint2 h[8]; };
  DI void pre(Pre& p, int brow, int pn, int wv, int lane) const {
#pragma unroll
    for (int q = 0; q < 8; ++q) p.h[q] = *(const uint2*)(hb + (size_t)(brow + wv + q * 8) * D_ + pn * 256 + lane * 4);
  }
  DI void operator()(const Pre& p, const float* stg, int brow, int pn, int wv, int lane) const {
#pragma unroll
    for (int q = 0; q < 8; ++q) {
      const int rr = wv + q * 8, row = brow + rr;
      const size_t idx = (size_t)row * D_ + pn * 256 + lane * 4;
      const uint2 xw = p.h[q];
      f32x4 hv = {bf2f((u16)(xw.x & 0xffff)), bf2f((u16)(xw.x >> 16)), bf2f((u16)(xw.y & 0xffff)), bf2f((u16)(xw.y >> 16))};
      hv = hv + *(const f32x4*)(stg + rr * STG_LD + lane * 4) * scale;
      if (fout) *(f32x4*)(fout + idx) = hv;
      uint2 w; w.x = pack2(hv[0], hv[1]); w.y = pack2(hv[2], hv[3]);
      *(uint2*)(hb + idx) = w;
      if (ssq_next) {
        float sq = hv[0] * hv[0] + hv[1] * hv[1] + hv[2] * hv[2] + hv[3] * hv[3];
#pragma unroll
        for (int o = 1; o < 64; o <<= 1) sq += __shfl_xor(sq, o);
        if (lane == 0) ssq_next[(size_t)row * 4 + pn] = sq;
      }
    }
  }
};

struct EpiLruGate {
  static constexpr bool REGMODE = false;
  DI void reg(const AccT&, char*, int, int, int) const {}
  const float* ba; const float* bx; const float* lam; const u16* xc; float* a; float* b;
  struct Pre {};
  DI void pre(Pre&, int, int, int, int) const {}
  DI void operator()(const Pre&, const float* stg, int brow, int pn, int wv, int lane) const {
    const int l32 = lane & 31;
    const int ch = (pn >> 1) * 256 + (pn & 1) * 128 + l32 * 4;
    const f32x4 vba = *(const f32x4*)(ba + ch), vbx = *(const f32x4*)(bx + ch), vl = *(const f32x4*)(lam + ch);
    f32x4 sp;
#pragma unroll
    for (int j = 0; j < 4; ++j) sp[j] = __logf(1.f + __expf(-vl[j]));
#pragma unroll 2
    for (int rp = wv; rp < 32; rp += 8) {
      const int rr = rp * 2 + (lane >> 5), row = brow + rr;
      const size_t idx = (size_t)row * D_ + ch;
      const uint2 xw = *(const uint2*)(xc + idx);
      const float xv[4] = {bf2f((u16)(xw.x & 0xffff)), bf2f((u16)(xw.x >> 16)), bf2f((u16)(xw.y & 0xffff)), bf2f((u16)(xw.y >> 16))};
      const f32x4 ra = *(const f32x4*)(stg + rr * STG_LD + l32 * 4), ia = *(const f32x4*)(stg + rr * STG_LD + 128 + l32 * 4);
      f32x4 av, bv;
#pragma unroll
      for (int j = 0; j < 4; ++j) {
        const float r = sigmoidf(ra[j] + vba[j]), ig = sigmoidf(ia[j] + vbx[j]);
        const float la = -8.f * r * sp[j];
        const float x2 = 2.f * la;
        float mult = sqrtf((x2 > -0.05f) ? -x2 * (1.f + x2 * (0.5f + x2 * (0.16666667f + x2 * 0.041666667f))) : 1.f - __expf(x2));
        if ((row & (S_ - 1)) == 0) mult = 1.f;
        av[j] = __expf(la); bv[j] = mult * ig * xv[j];
      }
      *(f32x4*)(a + idx) = av; *(f32x4*)(b + idx) = bv;
    }
  }
};

constexpr int KLD = 72;
#define MFMA32(a, b, c) __builtin_amdgcn_mfma_f32_32x32x16_bf16((a), (b), (c), 0, 0, 0)

DI int keyoff(int sb, int i, int hf) { return sb * 32 + (i >> 2) * 8 + hf * 4 + (i & 3); }

DI void qk_scores(const u16* Ks, const bf16x8 (&qf)[4], int lane, f32x16 (&s)[2]) {
  const int r = lane & 31, hf = lane >> 5;
#pragma unroll
  for (int sb = 0; sb < 2; ++sb) {
    f32x16 acc = {};
#pragma unroll
    for (int st = 0; st < 4; ++st) {
      const bf16x8 a = *(const bf16x8*)(Ks + (sb * 32 + r) * KLD + st * 16 + hf * 8);
      acc = MFMA32(a, qf[st], acc);
    }
    s[sb] = acc;
  }
}

DI void pv_acc(const u16* Vs, const f32x16 (&p)[2], f32x16 (&o)[2], int lane) {
  const int r = lane & 31, hf = lane >> 5;
#pragma unroll
  for (int sb = 0; sb < 2; ++sb)
#pragma unroll
    for (int c = 0; c < 2; ++c) {
      union { bf16x8 v; unsigned u[4]; } pb;
#pragma unroll
      for (int q = 0; q < 4; ++q) pb.u[q] = pack2(p[sb][8 * c + 2 * q], p[sb][8 * c + 2 * q + 1]);
#pragma unroll
      for (int db = 0; db < 2; ++db) {
        const u16* vp = Vs + (db * 32 + r) * KLD + sb * 32 + c * 16 + hf * 4;
        union { bf16x8 v; s16x4 h[2]; } a;
        a.h[0] = *(const s16x4*)(vp); a.h[1] = *(const s16x4*)(vp + 8);
        o[db] = MFMA32(a.v, pb.v, o[db]);
      }
    }
}

template <class VF>
DI void softmax_pv(const u16* Vs, f32x16 (&s)[2], float& m, float& l, f32x16 (&o)[2], int lane, VF validf) {
  const int hf = lane >> 5;
  float ls = 0.f;
#pragma unroll
  for (int sb = 0; sb < 2; ++sb)
#pragma unroll
    for (int i = 0; i < 16; ++i) { const float pv = validf(keyoff(sb, i, hf)) ? __builtin_amdgcn_exp2f(s[sb][i]) : 0.f; s[sb][i] = pv; ls += pv; }
  l += ls;
  pv_acc(Vs, s, o, lane);
}

DI void softmax_pv_lane(const u16* Vs, f32x16 (&s)[2], float& m, float& l, f32x16 (&o)[2], int lane, bool lv) {
  const float me = lv ? 0.f : 1e30f;
  float ls = 0.f;
#pragma unroll
  for (int sb = 0; sb < 2; ++sb)
#pragma unroll
    for (int i = 0; i < 16; ++i) { const float pv = __builtin_amdgcn_exp2f(s[sb][i] - me); s[sb][i] = pv; ls += pv; }
  l += ls;
  pv_acc(Vs, s, o, lane);
}

DI void prob_lane(f32x16 (&s)[2], float& l, bool lv) {
  const float me = lv ? 0.f : 1e30f;
  float ls = 0.f;
#pragma unroll
  for (int sb = 0; sb < 2; ++sb)
#pragma unroll
    for (int i = 0; i < 16; ++i) { const float pv = __builtin_amdgcn_exp2f(s[sb][i] - me); s[sb][i] = pv; ls += pv; }
  l += ls;
}
template <class VF>
DI void prob_elem(f32x16 (&s)[2], float& l, int lane, VF validf) {
  const int hf = lane >> 5;
  float ls = 0.f;
#pragma unroll
  for (int sb = 0; sb < 2; ++sb)
#pragma unroll
    for (int i = 0; i < 16; ++i) { const float pv = validf(keyoff(sb, i, hf)) ? __builtin_amdgcn_exp2f(s[sb][i]) : 0.f; s[sb][i] = pv; ls += pv; }
  l += ls;
}

DI void kv_load(int tid, const u16* kb, int kld, const u16* vb, int vld, int key0, uint4& kr, uint4& vr) {
  const int r = tid >> 3, seg = tid & 7;
  kr = *(const uint4*)(kb + (size_t)(key0 + r) * kld + seg * 8);
  vr = *(const uint4*)(vb + (size_t)r * vld + key0 + seg * 8);
}
DI void kv_store(int tid, u16* Ks, u16* Vs, const uint4& kr, const uint4& vr) {
  const int r = tid >> 3, seg = tid & 7;
  *(uint4*)(Ks + r * KLD + seg * 8) = kr;
  *(uint4*)(Vs + r * KLD + seg * 8) = vr;
}

template <class TF>
DI void attn_loop(int tid, const int* list, int cnt, const u16* kb, int kld, const u16* vb, int vld, u16* Ks, u16* Vs, TF f) {
  constexpr int BUFO = 2 * 64 * KLD;
  uint4 k0r, v0r, k1r, v1r;
  if (cnt > 0) kv_load(tid, kb, kld, vb, vld, list[0], k0r, v0r);
  if (cnt > 1) kv_load(tid, kb, kld, vb, vld, list[1], k1r, v1r);
  if (cnt > 0) kv_store(tid, Ks, Vs, k0r, v0r);
  __syncthreads();
  for (int it = 0; it < cnt; it += 2) {
    if (it + 2 < cnt) kv_load(tid, kb, kld, vb, vld, list[it + 2], k0r, v0r);
    f(list[it], Ks, Vs);
    if (it + 1 < cnt) kv_store(tid, Ks + BUFO, Vs + BUFO, k1r, v1r);
    __syncthreads();
    if (it + 1 < cnt) {
      if (it + 3 < cnt) kv_load(tid, kb, kld, vb, vld, list[it + 3], k1r, v1r);
      f(list[it + 1], Ks + BUFO, Vs + BUFO);
      if (it + 2 < cnt) kv_store(tid, Ks, Vs, k0r, v0r);
      __syncthreads();
    }
  }
}

template <class TF>
DI void attn_loop_p2(int tid, const int* list, int cnt, const u16* kb, int kld, const u16* vb, int vld, u16* Ks, TF f) {
  constexpr int BUFO = 2 * 64 * KLD;
  if (cnt <= 0) return;
  uint4 k0r, v0r, k1r, v1r;
  kv_load(tid, kb, kld, vb, vld, list[0], k0r, v0r);
  kv_load(tid, kb, kld, vb, vld, list[1], k1r, v1r);
  kv_store(tid, Ks, Ks + 64 * KLD, k0r, v0r);
  kv_store(tid, Ks + BUFO, Ks + BUFO + 64 * KLD, k1r, v1r);
  __syncthreads();
  for (int it = 0; it < cnt; it += 2) {
    const int base = ((it >> 1) & 1) * 2;
    u16* Ka = Ks + base * BUFO; u16* Kb = Ka + BUFO;
    u16* Na = Ks + (2 - base) * BUFO; u16* Nb = Na + BUFO;
    if (it + 2 < cnt) { kv_load(tid, kb, kld, vb, vld, list[it + 2], k0r, v0r); kv_load(tid, kb, kld, vb, vld, list[it + 3], k1r, v1r); }
    f(list[it], Ka, Ka + 64 * KLD);
    f(list[it + 1], Kb, Kb + 64 * KLD);
    if (it + 2 < cnt) { kv_store(tid, Na, Na + 64 * KLD, k0r, v0r); kv_store(tid, Nb, Nb + 64 * KLD, k1r, v1r); }
    __syncthreads();
  }
}

template <bool keep>
DI void load_q(const u16* qrow, const float* gain, float scale, int lane, bf16x8 (&qf)[4], float (&qn)[32]) {
  const int hf = lane >> 5;
  float v[32]; float ss = 0.f;
#pragma unroll
  for (int st = 0; st < 4; ++st) {
    const uint4 w = *(const uint4*)(qrow + st * 16 + hf * 8);
    const unsigned uu[4] = {w.x, w.y, w.z, w.w};
#pragma unroll
    for (int q = 0; q < 4; ++q) { v[st * 8 + 2 * q] = bf2f((u16)(uu[q] & 0xffff)); v[st * 8 + 2 * q + 1] = bf2f((u16)(uu[q] >> 16)); }
  }
#pragma unroll
  for (int i = 0; i < 32; ++i) ss += v[i] * v[i];
  ss += __shfl_xor(ss, 32);
  const float rs = rsqrtf(ss * (1.f / 64.f) + EPS_);
#pragma unroll
  for (int st = 0; st < 4; ++st) {
    union { bf16x8 v8; unsigned u[4]; } pk;
#pragma unroll
    for (int q = 0; q < 4; ++q) {
      const int d0 = st * 16 + hf * 8 + 2 * q;
      const float a = v[st * 8 + 2 * q] * rs * gain[d0], b = v[st * 8 + 2 * q + 1] * rs * gain[d0 + 1];
      if (keep) { qn[st * 8 + 2 * q] = a; qn[st * 8 + 2 * q + 1] = b; }
      pk.u[q] = pack2(a * scale, b * scale);
    }
    qf[st] = pk.v8;
  }
}

DI void acc_out(f32x16 (&tot)[2], const f32x16 (&o)[2], float w) {
#pragma unroll
  for (int db = 0; db < 2; ++db) tot[db] = tot[db] + o[db] * w;
}
DI void store_out(u16* orow, const f32x16 (&tot)[2], int lane) {
  const int hf = lane >> 5;
#pragma unroll
  for (int db = 0; db < 2; ++db)
#pragma unroll
    for (int gq = 0; gq < 4; ++gq) {
      uint2 w; w.x = pack2(tot[db][gq * 4 + 0], tot[db][gq * 4 + 1]); w.y = pack2(tot[db][gq * 4 + 2], tot[db][gq * 4 + 3]);
      *(uint2*)(orow + db * 32 + gq * 8 + hf * 4) = w;
    }
}

DI void moba_prep(const u16* RAW, const float* kgain, u16* KN, u16* VT, float* KMEAN, char* shm) {
  float* tile = (float*)shm;
  float* part = tile + 256 * 65;
  const int tid = tidx();
  for (int item = bidx(); item < 1024; item += gdim()) {
    const int h = item & 15, n = (item >> 4) & 15, b = item >> 8;
    const int t0 = b * S_ + n * 256;
    {
      const int tk = tid >> 1, half = tid & 1;
      const u16* src = RAW + (size_t)(t0 + tk) * 3072 + 1024 + h * 64 + half * 32;
      float v[32]; float ss = 0.f;
#pragma unroll
      for (int q4 = 0; q4 < 4; ++q4) {
        const uint4 w = *(const uint4*)(src + q4 * 8);
        const unsigned uu[4] = {w.x, w.y, w.z, w.w};
#pragma unroll
        for (int q = 0; q < 4; ++q) { v[q4 * 8 + 2 * q] = bf2f((u16)(uu[q] & 0xffff)); v[q4 * 8 + 2 * q + 1] = bf2f((u16)(uu[q] >> 16)); }
      }
#pragma unroll
      for (int i = 0; i < 32; ++i) ss += v[i] * v[i];
      ss += __shfl_xor(ss, 1);
      const float rs = rsqrtf(ss * (1.f / 64.f) + EPS_);
      u16* dst = KN + (size_t)(t0 + tk) * 1024 + h * 64 + half * 32;
#pragma unroll
      for (int q4 = 0; q4 < 4; ++q4) {
        uint4 w; unsigned uu[4];
#pragma unroll
        for (int q = 0; q < 4; ++q) {
          const int d = half * 32 + q4 * 8 + 2 * q;
          const float a = v[q4 * 8 + 2 * q] * rs * kgain[d], bb = v[q4 * 8 + 2 * q + 1] * rs * kgain[d + 1];
          tile[tk * 65 + d] = a; tile[tk * 65 + d + 1] = bb;
          uu[q] = pack2(a, bb);
        }
        w.x = uu[0]; w.y = uu[1]; w.z = uu[2]; w.w = uu[3];
        *(uint4*)(dst + q4 * 8) = w;
      }
    }
    __syncthreads();
    { const int d = tid & 63, pt = tid >> 6; float s = 0.f;
      for (int i = 0; i < 32; ++i) s += tile[(pt * 32 + i) * 65 + d];
      part[pt * 64 + d] = s; }
    __syncthreads();
    if (tid < 64) { float s = 0.f; for (int i = 0; i < 8; ++i) s += part[i * 64 + tid];
      KMEAN[((size_t)(b * 16 + h) * 16 + n) * 64 + tid] = s * (1.f / 256.f); }
    __syncthreads();
    {
      u16* vt = (u16*)shm;
      const int tk = tid >> 1, half = tid & 1;
      const u16* src = RAW + (size_t)(t0 + tk) * 3072 + 2048 + h * 64 + half * 32;
#pragma unroll
      for (int q4 = 0; q4 < 4; ++q4) {
        const uint4 w = *(const uint4*)(src + q4 * 8);
        unsigned* dp = (unsigned*)(vt + tk * 66 + half * 32 + q4 * 8);
        dp[0] = w.x; dp[1] = w.y; dp[2] = w.z; dp[3] = w.w;
      }
      __syncthreads();
      const int d = tid >> 3, ts = (tid & 7) * 32;
      u16* dst = VT + ((size_t)(b * 1024 + h * 64 + d)) * S_ + n * 256 + ts;
#pragma unroll
      for (int q4 = 0; q4 < 4; ++q4) {
        uint4 w; unsigned uu[4];
#pragma unroll
        for (int q = 0; q < 4; ++q) uu[q] = (unsigned)vt[(ts + q4 * 8 + 2 * q) * 66 + d] | ((unsigned)vt[(ts + q4 * 8 + 2 * q + 1) * 66 + d] << 16);
        w.x = uu[0]; w.y = uu[1]; w.z = uu[2]; w.w = uu[3];
        *(uint4*)(dst + q4 * 8) = w;
      }
    }
    __syncthreads();
  }
}

DI void moba_attn(const u16* RAW, const float* qgain, const u16* KN, const u16* VT, const float* KMEAN, u16* O, char* shm) {
  u16* Ks = (u16*)shm; u16* Vs = Ks + 64 * KLD;
  float* km = (float*)(Ks + 8 * 64 * KLD);
  int* list = (int*)(km + 16 * 64);
  int* misc = list + 64;
  const int tid = tidx(), wv = tid >> 6, lane = tid & 63, r = lane & 31, hf = lane >> 5;
  for (int it0 = bidx(); it0 < 1024; it0 += gdim()) {
    const int rnd = it0 >> 8, idx = it0 & 255, grp = idx >> 6, sub = idx & 63;
    const int own = (rnd == 0) ? 15 - grp : (rnd == 1) ? 8 + grp : (rnd == 2) ? 7 - grp : grp;
    const int b = sub >> 4, h = sub & 15;
    const int pos = own * 256 + wv * 32 + r;
    const size_t tok = (size_t)b * S_ + pos;
    for (int i = tid; i < 1024; i += 512) km[i] = KMEAN[(size_t)(b * 16 + h) * 1024 + i];
    if (tid == 0) misc[0] = 0;
    bf16x8 qf[4]; float qn[32];
    load_q<true>(RAW + tok * 3072 + h * 64, qgain, 0.125f * LOG2E, lane, qf, qn);
    __syncthreads();
    float v0 = -3e38f, v1 = -3e38f, v2 = -3e38f; int i0 = -1, i1 = -1, i2 = -1;
    for (int n = 0; n < own; ++n) {
      float gsum = 0.f;
#pragma unroll
      for (int st = 0; st < 4; ++st)
#pragma unroll
        for (int j = 0; j < 8; ++j) gsum += qn[st * 8 + j] * km[n * 64 + st * 16 + hf * 8 + j];
      gsum += __shfl_xor(gsum, 32);
      if (gsum > v0) { v2 = v1; i2 = i1; v1 = v0; i1 = i0; v0 = gsum; i0 = n; }
      else if (gsum > v1) { v2 = v1; i2 = i1; v1 = gsum; i1 = n; }
      else if (gsum > v2) { v2 = gsum; i2 = n; }
    }
    unsigned mymask = 0;
    if (i0 >= 0) mymask |= 1u << i0;
    if (i1 >= 0) mymask |= 1u << i1;
    if (i2 >= 0) mymask |= 1u << i2;
    unsigned wor = mymask;
#pragma unroll
    for (int o = 1; o < 64; o <<= 1) wor |= (unsigned)__shfl_xor((int)wor, o);
    if (lane == 0) atomicOr((unsigned*)&misc[0], wor);
    __syncthreads();
    if (tid == 0) {
      const unsigned un = (unsigned)misc[0]; int c = 0;
      for (int n = 0; n <= own; ++n) if (n == own || ((un >> n) & 1)) for (int kt = 0; kt < 4; ++kt) list[c++] = n * 256 + kt * 64;
      misc[1] = c;
    }
    __syncthreads();
    const int cnt = misc[1];
    f32x16 o[2] = {}; float m = -1e30f, l = 0.f;
    const int wmax = own * 256 + wv * 32 + 31;
    attn_loop_p2(tid, list, cnt, KN + (size_t)b * S_ * 1024 + h * 64, 1024, VT + (size_t)(b * 1024 + h * 64) * S_, S_, Ks, [&](int key0, const u16* Ks, const u16* Vs) {
      const int n = key0 >> 8;
      const bool need = (n == own) ? (key0 <= wmax) : ((wor >> n) & 1);
      if (need) {
        f32x16 s[2];
        qk_scores(Ks, qf, lane, s);
        if (n != own) prob_lane(s, l, (mymask >> n) & 1);
        else if (key0 + 63 <= wmax - 31) prob_lane(s, l, true);
        else prob_elem(s, l, lane, [&](int ko) { return key0 + ko <= pos; });
        pv_acc(Vs, s, o, lane);
      }
    });
    l += __shfl_xor(l, 32);
    f32x16 tot[2] = {};
    acc_out(tot, o, 1.f / l);
    store_out(O + tok * 1024 + h * 64, tot, lane);
  }
}

DI void lru_conv(const u16* RAW, const float* cw, const float* cb, u16* XC) {
  const int nth = gdim() * 512;
  for (int i = bidx() * 512 + tidx(); i < T_ * 128; i += nth) {
    const int t = i >> 7, c0 = (i & 127) * 8, ts = t & (S_ - 1);
    float acc[8];
#pragma unroll
    for (int j = 0; j < 8; ++j) acc[j] = cb[c0 + j];
#pragma unroll
    for (int k = 0; k < 4; ++k) {
      if (ts - 3 + k >= 0) {
        const uint4 w = *(const uint4*)(RAW + (size_t)(t - 3 + k) * 2048 + c0);
        const unsigned uu[4] = {w.x, w.y, w.z, w.w};
#pragma unroll
        for (int q = 0; q < 4; ++q) {
          acc[2 * q] += cw[k * 1024 + c0 + 2 * q] * bf2f((u16)(uu[q] & 0xffff));
          acc[2 * q + 1] += cw[k * 1024 + c0 + 2 * q + 1] * bf2f((u16)(uu[q] >> 16));
        }
      }
    }
    uint4 w; w.x = pack2(acc[0], acc[1]); w.y = pack2(acc[2], acc[3]); w.z = pack2(acc[4], acc[5]); w.w = pack2(acc[6], acc[7]);
    *(uint4*)(XC + (size_t)t * 1024 + c0) = w;
  }
}

DI void lru_scan1(const float* A, const float* Bv, float* PC, float* HC) {
  const int tid = tidx();
  for (int vb = bidx(); vb < 256; vb += gdim()) {
    const int gi = vb * 512 + tid, cg = gi & 255, c = (gi >> 8) & 127, b = gi >> 15;
    const size_t base = ((size_t)b * S_ + c * 32) * 1024 + cg * 4;
    f32x4 hl = {0.f, 0.f, 0.f, 0.f}, P = {1.f, 1.f, 1.f, 1.f};
#pragma unroll 8
    for (int i = 0; i < 32; ++i) { const f32x4 a = *(const f32x4*)(A + base + (size_t)i * 1024), bb = *(const f32x4*)(Bv + base + (size_t)i * 1024); hl = a * hl + bb; P = P * a; }
    const size_t q = ((size_t)(b * 128 + c)) * 1024 + cg * 4;
    *(f32x4*)(PC + q) = P; *(f32x4*)(HC + q) = hl;
  }
}
DI void lru_scan2(const float* A, const float* Bv, const float* PC, const float* HC, const u16* RAW, u16* HY) {
  const int tid = tidx();
  for (int vb = bidx(); vb < 256; vb += gdim()) {
    const int gi = vb * 512 + tid, cg = gi & 255, c = (gi >> 8) & 127, b = gi >> 15;
    f32x4 h = {0.f, 0.f, 0.f, 0.f};
    {
      int cc = 0;
      for (; cc + 8 <= c; cc += 8) {
        f32x4 Pv[8], Hv[8];
#pragma unroll
        for (int u = 0; u < 8; ++u) { const size_t q = ((size_t)(b * 128 + cc + u)) * 1024 + cg * 4; Pv[u] = *(const f32x4*)(PC + q); Hv[u] = *(const f32x4*)(HC + q); }
#pragma unroll
        for (int u = 0; u < 8; ++u) h = Pv[u] * h + Hv[u];
      }
      for (; cc < c; ++cc) { const size_t q = ((size_t)(b * 128 + cc)) * 1024 + cg * 4; h = *(const f32x4*)(PC + q) * h + *(const f32x4*)(HC + q); }
    }
    const size_t t0 = (size_t)b * S_ + c * 32;
#pragma unroll 8
    for (int i = 0; i < 32; ++i) {
      const size_t t = t0 + i;
      h = *(const f32x4*)(A + t * 1024 + cg * 4) * h + *(const f32x4*)(Bv + t * 1024 + cg * 4);
      const uint2 yw = *(const uint2*)(RAW + t * 2048 + 1024 + cg * 4);
      uint2 w;
      w.x = pack2(h[0] * bf2f((u16)(yw.x & 0xffff)), h[1] * bf2f((u16)(yw.x >> 16)));
      w.y = pack2(h[2] * bf2f((u16)(yw.y & 0xffff)), h[3] * bf2f((u16)(yw.y >> 16)));
      *(uint2*)(HY + t * 1024 + cg * 4) = w;
    }
  }
}

DI void nsa_prep(const u16* RAW, const Params& p, char* scr, char* shm, int mode, int vbid, int vnb) {
  const int tid = tidx();
  const float* gate_b = p.in[20]; const float* ksg = p.in[23]; const float* kwg = p.in[24];
  const float* pos_k = p.in[25]; const float* pos_v = p.in[26];
  u16* KSN = (u16*)(scr + N_KSN); u16* KWN = (u16*)(scr + N_KWN); u16* VST = (u16*)(scr + N_VST); u16* VWT = (u16*)(scr + N_VWT);
  u16* AK = (u16*)(scr + N_AK); u16* AV = (u16*)(scr + N_AV); float* GATES = (float*)(scr + N_GATES);
  if (mode == 2)
  for (int item = vbid; item < 512; item += vnb) {
    const int which = item & 1, g = (item >> 1) & 3, n = (item >> 3) & 15, b = item >> 7;
    const int t0 = b * S_ + n * 256;
    const int kcol = (which ? 2048 : 1536) + g * 64, vcol = (which ? 2304 : 1792) + g * 64;
    const float* gain = which ? kwg : ksg;
    u16* KNo = which ? KWN : KSN; u16* VTo = which ? VWT : VST;
    {
      const int tk = tid >> 1, half = tid & 1;
      const u16* src = RAW + (size_t)(t0 + tk) * 2816 + kcol + half * 32;
      float v[32]; float ss = 0.f;
#pragma unroll
      for (int q4 = 0; q4 < 4; ++q4) {
        const uint4 w = *(const uint4*)(src + q4 * 8);
        const unsigned uu[4] = {w.x, w.y, w.z, w.w};
#pragma unroll
        for (int q = 0; q < 4; ++q) { v[q4 * 8 + 2 * q] = bf2f((u16)(uu[q] & 0xffff)); v[q4 * 8 + 2 * q + 1] = bf2f((u16)(uu[q] >> 16)); }
      }
#pragma unroll
      for (int i = 0; i < 32; ++i) ss += v[i] * v[i];
      ss += __shfl_xor(ss, 1);
      const float rs = rsqrtf(ss * (1.f / 64.f) + EPS_);
      u16* dst = KNo + (size_t)(t0 + tk) * 256 + g * 64 + half * 32;
#pragma unroll
      for (int q4 = 0; q4 < 4; ++q4) {
        unsigned uu[4];
#pragma unroll
        for (int q = 0; q < 4; ++q) { const int d = half * 32 + q4 * 8 + 2 * q; uu[q] = pack2(v[q4 * 8 + 2 * q] * rs * gain[d], v[q4 * 8 + 2 * q + 1] * rs * gain[d + 1]); }
        uint4 w; w.x = uu[0]; w.y = uu[1]; w.z = uu[2]; w.w = uu[3];
        *(uint4*)(dst + q4 * 8) = w;
      }
    }
    {
      u16* vt = (u16*)shm;
      const int tk = tid >> 1, half = tid & 1;
      const u16* src = RAW + (size_t)(t0 + tk) * 2816 + vcol + half * 32;
#pragma unroll
      for (int q4 = 0; q4 < 4; ++q4) {
        const uint4 w = *(const uint4*)(src + q4 * 8);
        unsigned* dp = (unsigned*)(vt + tk * 66 + half * 32 + q4 * 8);
        dp[0] = w.x; dp[1] = w.y; dp[2] = w.z; dp[3] = w.w;
      }
      __syncthreads();
      const int d = tid >> 3, ts = (tid & 7) * 32;
      u16* dst = VTo + ((size_t)(b * 256 + g * 64 + d)) * S_ + n * 256 + ts;
#pragma unroll
      for (int q4 = 0; q4 < 4; ++q4) {
        unsigned uu[4];
#pragma unroll
        for (int q = 0; q < 4; ++q) uu[q] = (unsigned)vt[(ts + q4 * 8 + 2 * q) * 66 + d] | ((unsigned)vt[(ts + q4 * 8 + 2 * q + 1) * 66 + d] << 16);
        uint4 w; w.x = uu[0]; w.y = uu[1]; w.z = uu[2]; w.w = uu[3];
        *(uint4*)(dst + q4 * 8) = w;
      }
      __syncthreads();
    }
  }
  const int nth = vnb * 512, gt = vbid * 512 + tid;
  if (mode == 2)
  for (int i = gt; i < T_ * 48; i += nth) {
    const int t = i / 48, c = i - t * 48;
    GATES[i] = sigmoidf(bf2f(RAW[(size_t)t * 2816 + 2560 + c]) + gate_b[c]);
  }
  if (mode == 1)
  for (int i = gt; i < 4096 * 256; i += nth) {
    const int row = i >> 8, c8 = (i & 255) * 8, ii = c8 >> 6, d = c8 & 63;
    const int n = row & 255, g = (row >> 8) & 3, b = row >> 10;
    uint4 wk = make_uint4(0, 0, 0, 0), wv = wk;
    if (n < 255) {
      const size_t t = (size_t)b * S_ + n * 16 + ii;
      const uint4 rk = *(const uint4*)(RAW + t * 2816 + 1024 + g * 64 + d);
      const uint4 rv = *(const uint4*)(RAW + t * 2816 + 1280 + g * 64 + d);
      const unsigned ku[4] = {rk.x, rk.y, rk.z, rk.w}, vu[4] = {rv.x, rv.y, rv.z, rv.w};
      unsigned ko[4], vo[4];
#pragma unroll
      for (int q = 0; q < 4; ++q) {
        const int e = ii * 64 + d + 2 * q;
        ko[q] = pack2(bf2f((u16)(ku[q] & 0xffff)) + pos_k[e], bf2f((u16)(ku[q] >> 16)) + pos_k[e + 1]);
        vo[q] = pack2(bf2f((u16)(vu[q] & 0xffff)) + pos_v[e], bf2f((u16)(vu[q] >> 16)) + pos_v[e + 1]);
      }
      wk = make_uint4(ko[0], ko[1], ko[2], ko[3]); wv = make_uint4(vo[0], vo[1], vo[2], vo[3]);
    }
    *(uint4*)(AK + (size_t)row * 2048 + c8) = wk;
    *(uint4*)(AV + (size_t)row * 2048 + c8) = wv;
  }
}

DI void nsa_cmp2(const float* PART, const float* w2k, const float* w2v, const float* kcg, u16* KCMP, u16* VCMPT, char* shm) {
  const int tid = tidx(); const int wv = tid >> 6, lane = tid & 63;
  float* hbuf = (float*)shm + wv * 256;
  for (int rw = bidx() * 8 + wv; rw < 8192; rw += gdim() * 8) {
    const int which = rw >> 12, row = rw & 4095;
    const float* w2 = which ? w2v : w2k;
    {
      const float* pp = PART + (size_t)rw * 256 + lane * 4;
      f32x4 hsum = *(const f32x4*)(pp) + *(const f32x4*)(pp + (size_t)8192 * 256) + *(const f32x4*)(pp + (size_t)2 * 8192 * 256) + *(const f32x4*)(pp + (size_t)3 * 8192 * 256);
      f32x4 hg; hg[0] = bf2f(f2bf(gelu_t(hsum[0]))); hg[1] = bf2f(f2bf(gelu_t(hsum[1]))); hg[2] = bf2f(f2bf(gelu_t(hsum[2]))); hg[3] = bf2f(f2bf(gelu_t(hsum[3])));
      *(f32x4*)(hbuf + lane * 4) = hg;
    }
    float acc = 0.f;
#pragma unroll 8
    for (int k0 = 0; k0 < 256; k0 += 4) {
      const f32x4 hv = *(const f32x4*)(hbuf + k0);
      acc += hv[0] * w2[(k0 + 0) * 64 + lane];
      acc += hv[1] * w2[(k0 + 1) * 64 + lane];
      acc += hv[2] * w2[(k0 + 2) * 64 + lane];
      acc += hv[3] * w2[(k0 + 3) * 64 + lane];
    }
    if (which == 0) {
      float ss = acc * acc;
#pragma unroll
      for (int o = 1; o < 64; o <<= 1) ss += __shfl_xor(ss, o);
      const float rs = rsqrtf(ss * (1.f / 64.f) + EPS_);
      KCMP[(size_t)row * 64 + lane] = f2bf(acc * rs * kcg[lane]);
    } else {
      const int bg = row >> 8, n = row & 255;
      VCMPT[((size_t)bg * 64 + lane) * 256 + n] = f2bf(acc);
    }
  }
}

DI void nsa_attn(const u16* RAW, const Params& p, char* scr, char* shm) {
  const u16* KSN = (const u16*)(scr + N_KSN); const u16* KWN = (const u16*)(scr + N_KWN);
  const u16* VST = (const u16*)(scr + N_VST); const u16* VWT = (const u16*)(scr + N_VWT);
  const u16* KCMP = (const u16*)(scr + N_KCMP); const u16* VCMPT = (const u16*)(scr + N_VCMPT);
  const float* GATES = (const float*)(scr + N_GATES); u16* O = (u16*)(scr + N_O);
  const float* qgain = p.in[21];
  u16* Ks = (u16*)shm; u16* Vs = Ks + 64 * KLD;
  int* list = (int*)(Ks + 4 * 64 * KLD);
  unsigned* selm = (unsigned*)(list + 64);
  unsigned* misc = selm + 128;
  float* invs = (float*)(misc + 4);
  float* totl = invs + 256;
  float* impH = totl;
  const int tid = tidx(), wv = tid >> 6, lane = tid & 63, r = lane & 31, hf = lane >> 5;
  const int hh = wv & 3, qh = wv >> 2;
  for (int it0 = bidx(); it0 < 1024; it0 += gdim()) {
    const int rnd = it0 >> 8, idx = it0 & 255, sub = idx & 15, ci = idx >> 4;
    const int c = (rnd == 0) ? 63 - ci : (rnd == 1) ? 32 + ci : (rnd == 2) ? 31 - ci : ci;
    const int b = sub >> 2, g = sub & 3, h = g * 4 + hh;
    const int ql = qh * 32 + r;
    const int pos = c * 64 + ql;
    const size_t tok = (size_t)b * S_ + pos;
    bf16x8 qf[4]; float qn[32];
    load_q<false>(RAW + tok * 2816 + h * 64, qgain, 0.125f * LOG2E, lane, qf, qn);
    for (int i = tid; i < 4 * 64 * 65; i += 512) impH[i] = 0.f;
    const int ncmp = min(255, 4 * c + 3);
    const int ntile = (ncmp + 63) >> 6;
    if (tid < 64) list[tid] = tid * 64;
    __syncthreads();
    const u16* kcb = KCMP + (size_t)(b * 4 + g) * 256 * 64;
    const u16* vcb = VCMPT + (size_t)(b * 4 + g) * 64 * 256;
    float l = 0.f;
    f32x16 oc[2] = {};
    {
      float* myimp = impH + (hh * 64 + ql) * 65;
      attn_loop(tid, list, ntile, kcb, 64, vcb, 256, Ks, Vs, [&](int key0, const u16* Ks, const u16* Vs) {
        f32x16 s[2];
        qk_scores(Ks, qf, lane, s);
        float ls = 0.f;
#pragma unroll
        for (int sb = 0; sb < 2; ++sb)
#pragma unroll
          for (int i = 0; i < 16; ++i) { const int n = key0 + keyoff(sb, i, hf); const bool v = (n < 255) && (16 * n + 31 <= pos); const float pv = v ? __builtin_amdgcn_exp2f(s[sb][i]) : 0.f; s[sb][i] = pv; ls += pv; }
        l += ls;
        pv_acc(Vs, s, oc, lane);
#pragma unroll
        for (int sb = 0; sb < 2; ++sb)
#pragma unroll
          for (int gi = 0; gi < 4; ++gi) {
            const int j = (key0 >> 2) + sb * 8 + gi * 2 + hf;
            myimp[j] += s[sb][gi * 4] + s[sb][gi * 4 + 1] + s[sb][gi * 4 + 2] + s[sb][gi * 4 + 3];
          }
#pragma unroll
        for (int sb = 0; sb < 2; ++sb)
#pragma unroll
          for (int gi = 0; gi < 4; ++gi) {
            const int j = (key0 >> 2) + sb * 8 + gi * 2 + hf + 1;
            if (j < 64) myimp[j] += s[sb][gi * 4 + 3];
          }
      });
    }
    l += __shfl_xor(l, 32);
    const float invc = (l > 0.f) ? 1.f / l : 0.f;
    if (hf == 0) invs[hh * 64 + ql] = invc;
    __syncthreads();
    {
      unsigned un0 = 0, un1 = 0;
      for (int qq = 0; qq < 8; ++qq) {
        const int q = wv * 8 + qq;
        const int j = lane;
        float v = ((impH[(0 * 64 + q) * 65 + j] * invs[q] + impH[(1 * 64 + q) * 65 + j] * invs[64 + q]) + (impH[(2 * 64 + q) * 65 + j] * invs[128 + q] + impH[(3 * 64 + q) * 65 + j] * invs[192 + q]));
        const bool valid = j <= c;
        const bool forced = (j == 0) || (j == c) || (j == c - 1);
        v = valid ? (forced ? 1e30f : v) : -1e30f;
        int rank = 0;
#pragma unroll
        for (int k = 0; k < 64; ++k) {
          const float vk = __builtin_bit_cast(float, __builtin_amdgcn_readlane(__builtin_bit_cast(int, v), k));
          rank += (vk > v || (vk == v && k < j)) ? 1 : 0;
        }
        const unsigned long long bm = __ballot((rank < 16) && valid);
        if (lane == 0) { selm[q * 2] = (unsigned)bm; selm[q * 2 + 1] = (unsigned)(bm >> 32); }
        un0 |= (unsigned)bm; un1 |= (unsigned)(bm >> 32);
      }
      if (tid == 0) { misc[0] = 0; misc[1] = 0; }
      __syncthreads();
      if (lane == 0) { atomicOr(&misc[0], un0); atomicOr(&misc[1], un1); }
      __syncthreads();
      if (tid == 0) {
        const unsigned long long un = (unsigned long long)misc[0] | ((unsigned long long)misc[1] << 32);
        int cn = 0;
        for (int j = 0; j <= c; ++j) if ((un >> j) & 1) list[cn++] = j * 64;
        misc[2] = cn;
      }
      __syncthreads();
    }
    {
      const float gcv = GATES[tok * 48 + h * 3 + 0] * invc;
#pragma unroll
      for (int db = 0; db < 2; ++db)
#pragma unroll
        for (int i = 0; i < 16; ++i) totl[(db * 16 + i) * 512 + tid] = oc[db][i] * gcv;
    }
    {
      const unsigned long long mym = (unsigned long long)selm[ql * 2] | ((unsigned long long)selm[ql * 2 + 1] << 32);
      unsigned long long wm = mym;
      { unsigned lo = (unsigned)wm, hi = (unsigned)(wm >> 32);
#pragma unroll
        for (int o = 1; o < 32; o <<= 1) { lo |= (unsigned)__shfl_xor((int)lo, o); hi |= (unsigned)__shfl_xor((int)hi, o); }
        wm = (unsigned long long)lo | ((unsigned long long)hi << 32); }
      const int cnt = (int)misc[2];
      f32x16 o[2] = {}; float ms = -1e30f, lsum = 0.f;
      attn_loop(tid, list, cnt, KSN + (size_t)b * S_ * 256 + g * 64, 256, VST + (size_t)(b * 256 + g * 64) * S_, S_, Ks, Vs, [&](int key0, const u16* Ks, const u16* Vs) {
        const int j = key0 >> 6;
        if ((wm >> j) & 1) {
          f32x16 s[2];
          qk_scores(Ks, qf, lane, s);
          if (j != c) prob_lane(s, lsum, (mym >> j) & 1);
          else prob_elem(s, lsum, lane, [&](int ko) { return key0 + ko <= pos; });
          pv_acc(Vs, s, o, lane);
        }
      });
      lsum += __shfl_xor(lsum, 32);
      { const float w = GATES[tok * 48 + h * 3 + 1] / lsum;
#pragma unroll
      for (int db = 0; db < 2; ++db)
#pragma unroll
        for (int i = 0; i < 16; ++i) totl[(db * 16 + i) * 512 + tid] += o[db][i] * w; }
    }
    {
      const int j0 = max(0, c - 8);
      if (tid < 16) list[tid] = (j0 + tid) * 64;
      __syncthreads();
      f32x16 o[2] = {}; float mw = -1e30f, lsum = 0.f;
      attn_loop(tid, list, c - j0 + 1, KWN + (size_t)b * S_ * 256 + g * 64, 256, VWT + (size_t)(b * 256 + g * 64) * S_, S_, Ks, Vs, [&](int key0, const u16* Ks, const u16* Vs) {
        f32x16 s[2];
        qk_scores(Ks, qf, lane, s);
        const int jt = key0 >> 6;
        if (jt > c - 8 && jt < c) prob_lane(s, lsum, true);
        else prob_elem(s, lsum, lane, [&](int ko) { const int kp = key0 + ko; return (kp <= pos) && (kp > pos - 512); });
        pv_acc(Vs, s, o, lane);
      });
      lsum += __shfl_xor(lsum, 32);
      { const float w = GATES[tok * 48 + h * 3 + 2] / lsum;
#pragma unroll
      for (int db = 0; db < 2; ++db)
#pragma unroll
        for (int i = 0; i < 16; ++i) o[db][i] = totl[(db * 16 + i) * 512 + tid] + o[db][i] * w; }
      store_out(O + tok * 1024 + h * 64, o, lane);
    }
    __syncthreads();
  }
}

DI void op_init(const Params& p, char* shm) {
  const float* x = p.in[0];
  u16* HB = (u16*)(p.ws + OFF_HB); float* SSQ = (float*)(p.ws + OFF_SSQ);
  const int tid = tidx(); const int wv = tid >> 6, lane = tid & 63;
  for (int row = bidx() * 8 + wv; row < T_; row += gdim() * 8) {
    float ss = 0.f;
#pragma unroll
    for (int i = 0; i < 4; ++i) {
      const int col = (i * 64 + lane) * 4;
      const float4 v = *(const float4*)(x + (size_t)row * D_ + col);
      ss += v.x * v.x + v.y * v.y + v.z * v.z + v.w * v.w;
      uint2 w; w.x = pack2(v.x, v.y); w.y = pack2(v.z, v.w);
      *(uint2*)(HB + (size_t)row * D_ + col) = w;
    }
#pragma unroll
    for (int o = 1; o < 64; o <<= 1) ss += __shfl_xor(ss, o);
    if (lane < 4) SSQ[(size_t)row * 4 + lane] = (lane == 0) ? ss : 0.f;
  }
  convert_layer(p, 0, shm, (int)blockIdx.x, (int)gridDim.x, 1);
}

template <int OPC, int KINDC>
DI void run_op(const Params& p, int L, int op_rt, char* shm) {
  const int op = (OPC >= 0) ? OPC : op_rt;
  const int kind = (KINDC >= 0) ? KINDC : L % 3, j = L / 3;
  char* ws = p.ws;
  asm volatile("" : "+s"(ws));
  char* scr = ws + OFF_SCR;
  u16* WT = (u16*)(ws + (size_t)(L & 1) * WT_BYTES);
  u16* HB = (u16*)(ws + OFF_HB); float* SSQ = (float*)(ws + OFF_SSQ);
  u16* HID = (u16*)scr;
  switch (op) {
    case OP_INIT: op_init(p, shm); break;
    case OP_UP1: case OP_UP2: {
      const int w = (op == OP_UP1) ? 0 : 2;
      GemmArgs g{HB, D_, WT + (w ? W_UP2 : W_UP1), D_, T_, 2 * F_, D_, -1, -1};
      gemm_phase(g, EpiSwiglu{HID, SSQ + (size_t)w * SSQ_STRIDE}, shm);
      if (op == OP_UP1) { if (L == 0) convert_on_idle(p, 0, shm, (T_ / 256) * (2 * F_ / 256), 2); }
      else convert_on_idle(p, L + 1, shm, (T_ / 256) * (2 * F_ / 256), 3);
    } break;
    case OP_DN1: case OP_DN2: {
      const bool first = (op == OP_DN1);
      GemmArgs g{HID, F_, WT + (first ? W_DN1 : W_DN2), F_, T_, D_, F_, -1, -1};
      float* nx = first ? SSQ + SSQ_STRIDE : (L < 3 ? SSQ : nullptr);
      if (PROBE_DUP & 64) { gemm_phase(g, EpiStore{(u16*)(scr + 100 * MB), D_, nullptr, 1 << 30}, shm); __syncthreads(); }
      gemm_phase(g, EpiResid{(!first && L == 3) ? p.out : nullptr, HB, nx, 0.5f}, shm);
    } break;
    case OP_IN: {
      const int N = (kind == 0) ? 3072 : (kind == 1) ? 2048 : 2816;
      GemmArgs g{HB, D_, WT + W_MIN, D_, T_, N, D_, -1, -1};
      if (kind == 0) gemm_phase(g, EpiMobaIn{(u16*)scr, SSQ + SSQ_STRIDE, p.in[8] + j * 64, (u16*)(scr + A_KN), (u16*)(scr + A_VT), (float*)(scr + A_KMEAN)}, shm);
      else gemm_phase(g, EpiStore{(u16*)scr, N, SSQ + SSQ_STRIDE, (kind == 1) ? 1024 : (1 << 30)}, shm);
    } break;
    case OP_OUT: {
      const u16* Oa = (const u16*)(scr + L_HY);
      GemmArgs g{Oa, D_, WT + W_MOUT, D_, T_, D_, D_, -1, -1};
      if (PROBE_DUP & 64) { gemm_phase(g, EpiStore{(u16*)(scr + 100 * MB), D_, nullptr, 1 << 30}, shm); __syncthreads(); }
      gemm_phase(g, EpiResid{nullptr, HB, SSQ + 2 * SSQ_STRIDE, 1.0f}, shm);
    } break;
    case OP_M1:
      if (kind == 0) moba_prep((const u16*)scr, p.in[8] + j * 64, (u16*)(scr + A_KN), (u16*)(scr + A_VT), (float*)(scr + A_KMEAN), shm);
      else if (kind == 1) lru_conv((const u16*)scr, p.in[11], p.in[12], (u16*)(scr + L_XC));
      else nsa_prep((const u16*)scr, p, scr, shm, 1, (int)blockIdx.x, (int)gridDim.x);
      break;
    case OP_M2:
      if (kind == 0) moba_attn((const u16*)scr, p.in[7] + j * 64, (const u16*)(scr + A_KN), (const u16*)(scr + A_VT), (const float*)(scr + A_KMEAN), (u16*)(scr + A_O), shm);
      else if (kind == 1) {
        GemmArgs g{(const u16*)(scr + L_XC), D_, WT + W_EXT, 256, T_, 2048, 256, 1, -1};
        gemm_phase(g, EpiLruGate{p.in[14], p.in[16], p.in[17], (const u16*)(scr + L_XC), (float*)(scr + L_A), (float*)(scr + L_B)}, shm);
      } else {
        GemmArgs g1{(const u16*)(scr + N_AK), 2048, WT + W_EXT, 2048, 8192, 1024, 512, 0, 4, 1};
        gemm_phase(g1, EpiPartial{(float*)(scr + 176 * MB), 8192}, shm);
        { const int nb = (int)gridDim.x, bid = (int)blockIdx.x;
          if (nb > 128) { if (bid >= 128) nsa_prep((const u16*)scr, p, scr, shm, 2, bid - 128, nb - 128); }
          else nsa_prep((const u16*)scr, p, scr, shm, 2, bid, nb); }
      }
      break;
    case OP_M3:
      if (kind == 1) lru_scan1((const float*)(scr + L_A), (const float*)(scr + L_B), (float*)(ws + OFF_PC), (float*)(ws + OFF_HC));
      else if (kind == 2) nsa_cmp2((const float*)(scr + 176 * MB), p.in[28], p.in[30], p.in[22], (u16*)(scr + N_KCMP), (u16*)(scr + N_VCMPT), shm);
      break;
    case OP_M4:
      if (kind == 1) lru_scan2((const float*)(scr + L_A), (const float*)(scr + L_B), (const float*)(ws + OFF_PC), (const float*)(ws + OFF_HC), (const u16*)scr, (u16*)(scr + L_HY));
      else if (kind == 2) nsa_attn((const u16*)scr, p, scr, shm);
      break;
  }
}

#if MEGA
constexpr size_t OFF_BAR = 133 * MB;
constexpr int LDS_ST = 143360 - 32;
DI unsigned ld_agent(const unsigned* p) { return __hip_atomic_load(p, __ATOMIC_RELAXED, __HIP_MEMORY_SCOPE_AGENT); }
DI unsigned add_agent(unsigned* p) { return __hip_atomic_fetch_add(p, 1u, __ATOMIC_RELAXED, __HIP_MEMORY_SCOPE_AGENT); }
DI unsigned xcc_id() { return (unsigned)__builtin_amdgcn_s_getreg((3 << 11) | 20) & 0xFu; }
DI void bar_post(unsigned* bar) { if (tidx() == 0) (void)add_agent(&bar[1024 + 32 * xcc_id()]); }
DI void bar_setup(unsigned* bar, char* shm) {
  if (tidx() == 0) {
    const unsigned x = xcc_id(); unsigned nloc = 1, nx = 0;
    for (unsigned j = 0; j < 16; ++j) { const unsigned c = ld_agent(&bar[1024 + 32 * j]); nx += (c > 0u) ? 1u : 0u; if (j == x) nloc = c; }
    volatile unsigned* st = (volatile unsigned*)(shm + LDS_ST);
    st[0] = nloc; st[1] = nx; st[2] = x;
  }
  __syncthreads();
}
DI void grid_bar(unsigned* bar, char* shm) {
  asm volatile("s_waitcnt vmcnt(0)" ::: "memory");
  __syncthreads();
  if (tidx() == 0) {
    volatile unsigned* st = (volatile unsigned*)(shm + LDS_ST);
    const unsigned nloc = st[0], nx = st[1], x = st[2];
    const unsigned old = add_agent(&bar[32 * x]);
    const unsigned gen = old / nloc;
    if (old + 1u == (gen + 1u) * nloc) {
      __builtin_amdgcn_fence(__ATOMIC_RELEASE, "agent");
      asm volatile("s_waitcnt vmcnt(0)" ::: "memory");
      const unsigned og = add_agent(&bar[1536]);
      const unsigned tg = og / nx;
      if (og + 1u == (tg + 1u) * nx) (void)add_agent(&bar[1568]);
      else while (ld_agent(&bar[1568]) == tg) __builtin_amdgcn_s_sleep(1);
      __builtin_amdgcn_fence(__ATOMIC_ACQUIRE, "agent");
      (void)add_agent(&bar[512 + 32 * x]);
      asm volatile("s_waitcnt vmcnt(0)" ::: "memory");
    } else {
      while (ld_agent(&bar[512 + 32 * x]) == gen) __builtin_amdgcn_s_sleep(1);
      __builtin_amdgcn_fence(__ATOMIC_ACQUIRE, "agent");
      asm volatile("s_waitcnt vmcnt(0)" ::: "memory");
    }
  }
  __syncthreads();
}
typedef const __attribute__((address_space(4))) Params* KParams;
template <int OPC, int KINDC, bool SYNC>
DI void run_k(int L, char* shm) {
#if defined(__HIP_DEVICE_COMPILE__)
  KParams kp = (KParams)__builtin_amdgcn_kernarg_segment_ptr();
  asm volatile("" : "+s"(kp));
  const Params p = *kp;
  run_op<OPC, KINDC>(p, L, OPC, shm);
  {
    constexpr bool isA = (OPC == OP_UP1 || OPC == OP_UP2);
    constexpr bool isB = (OPC == OP_M2 && KINDC == 0) || (OPC == OP_M4 && KINDC == 2);
    constexpr bool isC = (OPC == OP_IN);
    constexpr bool isD = (OPC == OP_M1) || (OPC == OP_M3) || (OPC == OP_M2 && KINDC != 0) || (OPC == OP_M4 && KINDC == 1);
    if constexpr (((PROBE_DUP & 1) && isA) || ((PROBE_DUP & 2) && isB) || ((PROBE_DUP & 4) && isC) || ((PROBE_DUP & 8) && isD)) {
      __syncthreads();
      run_op<OPC, KINDC>(p, L, OPC, shm);
    }
  }
  if (SYNC) grid_bar((unsigned*)(p.ws + OFF_BAR), shm);
#endif
}
template <int L>
DI void run_layer(char* shm) {
  constexpr int kind = L % 3;
  run_k<OP_UP1, kind, true>(L, shm);
  run_k<OP_DN1, kind, true>(L, shm);
  run_k<OP_IN, kind, true>(L, shm);
  if constexpr (kind != 0) run_k<OP_M1, kind, true>(L, shm);
  run_k<OP_M2, kind, true>(L, shm);
  if constexpr (kind != 0) {
    run_k<OP_M3, kind, true>(L, shm);
    run_k<OP_M4, kind, true>(L, shm);
  }
  run_k<OP_OUT, kind, true>(L, shm);
  run_k<OP_UP2, kind, true>(L, shm);
  run_k<OP_DN2, kind, (L < 3)>(L, shm);
}
__global__ void __launch_bounds__(512) mega(Params pdummy, int lo, int hi, int coop) {
  extern __shared__ __attribute__((aligned(16))) char shm[];
  {
    KParams kp = (KParams)__builtin_amdgcn_kernarg_segment_ptr();
    bar_post((unsigned*)(kp->ws + OFF_BAR));
  }
  run_k<OP_INIT, -1, false>(0, shm);
  cg::this_grid().sync();
  {
    KParams kp = (KParams)__builtin_amdgcn_kernarg_segment_ptr();
    bar_setup((unsigned*)(kp->ws + OFF_BAR), shm);
  }
  run_layer<0>(shm);
  run_layer<1>(shm);
  run_layer<2>(shm);
  run_layer<3>(shm);
}
#endif
template <int OPC, int KINDC>
__global__ void __launch_bounds__(512) op_kernel(Params p, int L) {
  extern __shared__ __attribute__((aligned(16))) char shm[];
  run_op<OPC, KINDC>(p, L, OPC, shm);
}
template <int OPC, int KINDC>
static void launch_k(const Params& p, int L, int grid, size_t lds, hipStream_t stream) {
  static bool init = false;
  if (!init) { (void)hipFuncSetAttribute((const void*)op_kernel<OPC, KINDC>, hipFuncAttributeMaxDynamicSharedMemorySize, (int)lds); init = true; }
  op_kernel<OPC, KINDC><<<grid, 512, lds, stream>>>(p, L);
}
template <int OPC>
static void launch_op(const Params& p, int L, int grid, size_t lds, hipStream_t stream) {
  if constexpr (OPC == OP_IN || (OPC >= OP_M1 && OPC <= OP_M4)) {
    const int kind = L % 3;
    if (kind == 0) launch_k<OPC, 0>(p, L, grid, lds, stream);
    else if (kind == 1) launch_k<OPC, 1>(p, L, grid, lds, stream);
    else launch_k<OPC, 2>(p, L, grid, lds, stream);
  } else launch_k<OPC, -1>(p, L, grid, lds, stream);
}

extern "C" void kernel_launch(void* const* d_in, const int* in_sizes, int n_in, void* d_out, int out_size, void* d_ws, size_t ws_size,
                              hipStream_t stream) {
  constexpr size_t kDynLds = 140 * 1024;
  static int grid_blocks = 0;
  if (!grid_blocks) {
    int dev = 0, cus = 0;
    (void)hipGetDevice(&dev);
    (void)hipDeviceGetAttribute(&cus, hipDeviceAttributeMultiprocessorCount, dev);
#if MEGA
    (void)hipFuncSetAttribute((const void*)mega, hipFuncAttributeMaxDynamicSharedMemorySize, (int)kDynLds);
#endif
    grid_blocks = cus * 1;
  }
  Params p{};
  for (int i = 0; i < 32; ++i) p.in[i] = (const float*)d_in[i];
  p.out = (float*)d_out; p.ws = (char*)d_ws;
  int n = 0;
  p.prog[n++] = (0 << 4) | OP_INIT;
  for (int L = 0; L < 4; ++L) {
    const int kind = L % 3;
    p.prog[n++] = (L << 4) | OP_UP1; p.prog[n++] = (L << 4) | OP_DN1; p.prog[n++] = (L << 4) | OP_IN;
    p.prog[n++] = (L << 4) | OP_M1; p.prog[n++] = (L << 4) | OP_M2;
    if (kind != 0) { p.prog[n++] = (L << 4) | OP_M3; p.prog[n++] = (L << 4) | OP_M4; }
    p.prog[n++] = (L << 4) | OP_OUT; p.prog[n++] = (L << 4) | OP_UP2; p.prog[n++] = (L << 4) | OP_DN2;
  }
  p.nprog = n;
#if MEGA
  int lo = 0, hi = n, coop = 1;
  (void)hipMemsetAsync((char*)d_ws + OFF_BAR, 0, 8192, stream);
  void* args[] = {&p, &lo, &hi, &coop};
  hipError_t e = hipLaunchCooperativeKernel((void*)mega, dim3(grid_blocks), dim3(512), args, kDynLds, stream);
  if (e != hipSuccess) fprintf(stderr, "cooperative launch failed: %s (grid %d)\n", hipGetErrorString(e), grid_blocks);
#else
  for (int i = 0; i < n; ++i) {
    const int L = p.prog[i] >> 4, op = p.prog[i] & 15;
    switch (op) {
      case OP_INIT: launch_op<OP_INIT>(p, L, grid_blocks, kDynLds, stream); break;
      case OP_UP1: launch_op<OP_UP1>(p, L, grid_blocks, kDynLds, stream); break;
      case OP_DN1: launch_op<OP_DN1>(p, L, grid_blocks, kDynLds, stream); break;
      case OP_IN: launch_op<OP_IN>(p, L, grid_blocks, kDynLds, stream); break;
      case OP_M1: launch_op<OP_M1>(p, L, grid_blocks, kDynLds, stream); break;
      case OP_M2: launch_op<OP_M2>(p, L, grid_blocks, kDynLds, stream); break;
      case OP_M3: launch_op<OP_M3>(p, L, grid_blocks, kDynLds, stream); break;
      case OP_M4: launch_op<OP_M4>(p, L, grid_blocks, kDynLds, stream); break;
      case OP_OUT: launch_op<OP_OUT>(p, L, grid_blocks, kDynLds, stream); break;
      case OP_UP2: launch_op<OP_UP2>(p, L, grid_blocks, kDynLds, stream); break;
      case OP_DN2: launch_op<OP_DN2>(p, L, grid_blocks, kDynLds, stream); break;
    }
  }
#endif
}
```

```cpp
#include <hip/hip_runtime.h>
#include <hip/hip_cooperative_groups.h>
#include <stdint.h>
#include <cstdio>
namespace cg = cooperative_groups;

typedef unsigned short u16;
typedef short bf16x8 __attribute__((ext_vector_type(8)));
typedef short s16x4 __attribute__((ext_vector_type(4)));
typedef float f32x4 __attribute__((ext_vector_type(4)));
typedef float f32x16 __attribute__((ext_vector_type(16)));
#define DI __device__ __forceinline__

constexpr int T_ = 16384, S_ = 4096, D_ = 1024, F_ = 2816;
constexpr float EPS_ = 1e-6f;
constexpr float LOG2E = 1.4426950408889634f;

#ifndef PROBE_DUP
#define PROBE_DUP 0
#endif
#ifndef MEGA
#define MEGA 1
#endif

constexpr size_t MB = 1024 * 1024;
constexpr size_t WT_BYTES = 48 * MB;
constexpr size_t OFF_HB = 96 * MB;
constexpr size_t OFF_SSQ = 128 * MB;
constexpr size_t OFF_PC = 44 * MB;
constexpr size_t OFF_HC = 46 * MB;
constexpr size_t OFF_SCR = 134 * MB;
constexpr size_t SSQ_STRIDE = (size_t)T_ * 4;
constexpr size_t W_UP1 = 0, W_DN1 = W_UP1 + 5632 * 1024, W_UP2 = W_DN1 + 1024 * 2816, W_DN2 = W_UP2 + 5632 * 1024,
                 W_MIN = W_DN2 + 1024 * 2816, W_MOUT = W_MIN + 3072 * 1024, W_EXT = W_MOUT + 1024 * 1024;
constexpr size_t A_RAW = 0, A_KN = 104 * MB, A_VT = 136 * MB, A_O = 224 * MB, A_KMEAN = 200 * MB;
constexpr size_t L_RAW = 0, L_XC = 64 * MB, L_A = 96 * MB, L_B = 160 * MB, L_HY = 224 * MB;
constexpr size_t N_RAW = 0, N_KSN = 96 * MB, N_KWN = 104 * MB, N_VST = 112 * MB, N_VWT = 120 * MB, N_AK = 128 * MB,
                 N_AV = 144 * MB, N_HK = 162 * MB, N_HV = 164 * MB, N_KCMP = 166 * MB, N_VCMPT = 167 * MB, N_GATES = 168 * MB,
                 N_O = 224 * MB;

enum { OP_INIT = 0, OP_UP1, OP_DN1, OP_IN, OP_M1, OP_M2, OP_M3, OP_M4, OP_OUT, OP_UP2, OP_DN2 };

struct Params {
  const float* in[32];
  float* out;
  char* ws;
  int nprog;
  int pad0;
  unsigned char prog[64];
};

typedef __bf16 bf16x2_t __attribute__((ext_vector_type(2)));
typedef float f32x2_t __attribute__((ext_vector_type(2)));
DI unsigned pack2(float a, float b) { f32x2_t f = {a, b}; bf16x2_t h = __builtin_convertvector(f, bf16x2_t); return __builtin_bit_cast(unsigned, h); }
DI u16 f2bf(float x) { return (u16)(pack2(x, 0.f) & 0xffffu); }
DI float bf2f(u16 v) { return __uint_as_float(((unsigned)v) << 16); }
DI float gelu_t(float x) { float u = 1.5957691216057308f * (x + 0.044715f * x * x * x); return x * __builtin_amdgcn_rcpf(1.f + __expf(-u)); }
DI float sigmoidf(float x) { return __builtin_amdgcn_rcpf(1.f + __expf(-x)); }
DI int bidx() { int t = blockIdx.x; asm volatile("" : "+s"(t)); return t; }
DI int gdim() { int t = gridDim.x; asm volatile("" : "+s"(t)); return t; }
DI int tidx() { int t = threadIdx.x; asm volatile("" : "+v"(t)); return t; }

DI void conv_job(const float* src, const float* src2, int ld, int K, int R, int nvalid, int kind, const float* g, u16* dst, char* shm, int vbid, int vnb) {
  float* tile = (float*)shm;
  const int ntk = K / 64, ntr = R / 64, tid = tidx();
  for (int t = vbid; t < ntr * ntk; t += vnb) {
    const int tr = t / ntk, tk = t % ntk, r0 = tr * 64, k0 = tk * 64;
    const float* sp = src; int col0 = r0, nv = nvalid - r0, sld = ld;
    if (kind == 1) { int tile256 = r0 >> 8, within = r0 & 255, half = within >> 7, c = within & 127; col0 = half * 2816 + tile256 * 128 + c; nv = 64; }
    else if (kind == 2) { int pn = r0 >> 8, within = r0 & 255, half = within >> 7, c = within & 127; sp = (half ? src2 : src) + (size_t)(pn >> 1) * 65536; col0 = (pn & 1) * 128 + c; nv = 64; sld = 256; }
    {
      const int kk = tid >> 4, c4 = (tid & 15) * 4;
#pragma unroll
      for (int ps = 0; ps < 2; ++ps) {
        const int k = kk + ps * 32;
        float4 v = make_float4(0.f, 0.f, 0.f, 0.f);
        if (c4 < nv) v = *(const float4*)(sp + (size_t)(k0 + k) * sld + col0 + c4);
        const float gg = g ? g[k0 + k] : 1.f;
        tile[k * 65 + c4 + 0] = v.x * gg; tile[k * 65 + c4 + 1] = v.y * gg; tile[k * 65 + c4 + 2] = v.z * gg; tile[k * 65 + c4 + 3] = v.w * gg;
      }
    }
    __syncthreads();
    {
      const int n = tid >> 3, ks = (tid & 7) * 8;
      uint4 w;
      w.x = pack2(tile[(ks + 0) * 65 + n], tile[(ks + 1) * 65 + n]);
      w.y = pack2(tile[(ks + 2) * 65 + n], tile[(ks + 3) * 65 + n]);
      w.z = pack2(tile[(ks + 4) * 65 + n], tile[(ks + 5) * 65 + n]);
      w.w = pack2(tile[(ks + 6) * 65 + n], tile[(ks + 7) * 65 + n]);
      *(uint4*)(dst + (size_t)(r0 + n) * K + k0 + ks) = w;
    }
    __syncthreads();
  }
}

DI void convert_layer(const Params& p, int L, char* shm, int vbid, int vnb, int mask) {
  if (L >= 4) return;
  const int kind = L % 3, j = L / 3;
  u16* WT = (u16*)(p.ws + (size_t)(L & 1) * WT_BYTES);
  const float* ng = p.in[1] + (size_t)L * 3 * 1024;
  if (mask & 1) conv_job(p.in[2] + (size_t)L * 1024 * 5632, nullptr, 5632, 1024, 5632, 5632, 1, ng, WT + W_UP1, shm, vbid, vnb);
  if (!(mask & 2)) return;
  conv_job(p.in[3] + (size_t)L * 2816 * 1024, nullptr, 1024, 2816, 1024, 1024, 0, nullptr, WT + W_DN1, shm, vbid, vnb);
  conv_job(p.in[4] + (size_t)L * 1024 * 5632, nullptr, 5632, 1024, 5632, 5632, 1, ng + 2048, WT + W_UP2, shm, vbid, vnb);
  conv_job(p.in[5] + (size_t)L * 2816 * 1024, nullptr, 1024, 2816, 1024, 1024, 0, nullptr, WT + W_DN2, shm, vbid, vnb);
  if (kind == 0) {
    conv_job(p.in[6] + (size_t)j * 1024 * 3072, nullptr, 3072, 1024, 3072, 3072, 0, ng + 1024, WT + W_MIN, shm, vbid, vnb);
    conv_job(p.in[9] + (size_t)j * 1024 * 1024, nullptr, 1024, 1024, 1024, 1024, 0, nullptr, WT + W_MOUT, shm, vbid, vnb);
  } else if (kind == 1) {
    conv_job(p.in[10], nullptr, 2048, 1024, 2048, 2048, 0, ng + 1024, WT + W_MIN, shm, vbid, vnb);
    conv_job(p.in[18], nullptr, 1024, 1024, 1024, 1024, 0, nullptr, WT + W_MOUT, shm, vbid, vnb);
    conv_job(p.in[13], p.in[15], 256, 256, 2048, 2048, 2, nullptr, WT + W_EXT, shm, vbid, vnb);
  } else {
    conv_job(p.in[19], nullptr, 2608, 1024, 2816, 2608, 0, ng + 1024, WT + W_MIN, shm, vbid, vnb);
    conv_job(p.in[31], nullptr, 1024, 1024, 1024, 1024, 0, nullptr, WT + W_MOUT, shm, vbid, vnb);
    conv_job(p.in[27], nullptr, 256, 2048, 256, 256, 0, nullptr, WT + W_EXT, shm, vbid, vnb);
    conv_job(p.in[29], nullptr, 256, 2048, 256, 256, 0, nullptr, WT + W_EXT + 256 * 2048, shm, vbid, vnb);
  }
}
DI void convert_on_idle(const Params& p, int L, char* shm, int ntiles, int mask) {
  const int nb = (int)gridDim.x, bid = (int)blockIdx.x;
  const int rem = __builtin_amdgcn_readfirstlane(ntiles % nb);
  if (rem == 0) convert_layer(p, L, shm, bid, nb, mask);
  else if (bid >= rem) convert_layer(p, L, shm, bid - rem, nb - rem, mask);
}

constexpr int STG_LD = 260;
constexpr int BM = 256, BK = 64, HALF = 128, NXCD = 8, WGM = 8, HT = HALF * BK, SHM_B = 8 * HT * 2;

DI int lds_byte(int r, int c) {
  int st = (r >> 4) * 2 + (c >> 5), rr = r & 15, cc = c & 31, ob = rr * 64 + cc * 2;
  return st * 1024 + (ob ^ (((ob >> 9) & 1) << 5));
}
DI void stage_rc(int b, int& R, int& C) {
  int st = b / 1024, sb = b % 1024, swz = sb ^ (((sb >> 9) & 1) << 5);
  R = (st >> 1) * 16 + swz / 64; C = (st & 1) * 32 + (swz % 64) / 2;
}

DI void glds16(const void* sbase, unsigned voff, unsigned lds_addr) {
  unsigned keep;
  asm volatile("s_mov_b32 %0, m0\n\ts_mov_b32 m0, %3\n\ts_nop 0\n\tglobal_load_lds_dwordx4 %1, %2\n\ts_mov_b32 m0, %0"
               : "=&s"(keep) : "v"(voff), "s"(sbase), "s"(lds_addr) : "memory");
}
struct GemmArgs { const u16* A; int lda; const u16* Bt; int ldb; int M, N, K; int a_pn_shift; int b_pm_shift; };

template <class Epi>
DI void gemm_phase(const GemmArgs& g, const Epi& epi, char* shmc) {
  u16* shm = (u16*)shmc;
  const int tid_ = tidx();
  const int lda = g.lda, ldb = g.ldb, K = g.K;
#define SA(b, h) (shm + ((b)*4 + (h)) * HT)
#define SB(b, h) (shm + ((b)*4 + 2 + (h)) * HT)
#define STAGE(P, BASE, LD, br, kt)                                                                                  \
  do {                                                                                                              \
    const u16* _ub = (BASE) + ((long)(br) * (LD) + (long)(kt)*BK);                                                  \
    const unsigned _la = lds0 + (unsigned)((char*)(P) - shmc);     \
    glds16(_ub, so_##LD[0], _la);                                                                                   \
    glds16(_ub, so_##LD[1], _la + 8192u);                                                                           \
  } while (0)
#define LDA(dst, b, h)                                                                                              \
  for (int m = 0; m < 4; ++m) for (int k = 0; k < 2; ++k)                                                           \
    dst[m][k] = *reinterpret_cast<const bf16x8*>((char*)SA(b, h) + lds_byte(wr * 64 + m * 16 + fr, k * 32 + fq * 8))
#define LDB(dst, b, h)                                                                                              \
  for (int n = 0; n < 2; ++n) for (int k = 0; k < 2; ++k)                                                           \
    dst[n][k] = *reinterpret_cast<const bf16x8*>((char*)SB(b, h) + lds_byte(wc * 32 + n * 16 + fr, k * 32 + fq * 8))
#define MMA(ai, bj, At_, Bt_)                                                                                       \
  do {                                                                                                              \
    __builtin_amdgcn_s_setprio(1);                                                                                  \
    for (int m = 0; m < 4; ++m) for (int n = 0; n < 2; ++n) for (int k = 0; k < 2; ++k)                             \
      acc[ai][bj][m][n] = __builtin_amdgcn_mfma_f32_16x16x32_bf16(Bt_[n][k], At_[m][k], acc[ai][bj][m][n], 0, 0, 0); \
    __builtin_amdgcn_s_setprio(0);                                                                                  \
  } while (0)
#define WAIT_V(n) asm volatile("s_waitcnt vmcnt(" #n ")" ::: "memory")
#define WAIT_L(n) asm volatile("s_waitcnt lgkmcnt(" #n ")" ::: "memory")
#define BAR __builtin_amdgcn_s_barrier()
#define SCHED __builtin_amdgcn_sched_barrier(0)

  const int nM = g.M / BM, nN = g.N / BM, nwg = nM * nN;
  const int wid = tid_ >> 6, lane = tid_ & 63, wr = wid >> 2, wc = wid & 3, fr = lane & 15, fq = lane >> 4;
  int nt = K / BK;
  asm volatile("" : "+s"(nt));
  const unsigned lds0 = (unsigned)__builtin_amdgcn_readfirstlane((int)((unsigned)(size_t)(__attribute__((address_space(3))) char*)shmc + (unsigned)(tid_ & ~63) * 16u));
  unsigned so_lda[2], so_ldb[2];
  for (int _i = 0; _i < 2; ++_i) { int _r, _c; stage_rc(tid_ * 16 + _i * 8192, _r, _c); so_lda[_i] = (unsigned)(_r * lda + _c) * 2u; so_ldb[_i] = (unsigned)(_r * ldb + _c) * 2u; }
#define TILE_COORDS(tile_, pm_, pn_)                                                                               \
  do {                                                                                                              \
    int wgid = (tile_);                                                                                             \
    { int q = nwg / NXCD, r = nwg % NXCD, xcd = wgid % NXCD, off = wgid / NXCD; wgid = (xcd < r ? xcd * (q + 1) : r * (q + 1) + (xcd - r) * q) + off; } \
    int nig = WGM * nN, gid = wgid / nig, fm = gid * WGM, gsz = min(nM - fm, WGM);                                  \
    pm_ = fm + ((wgid % nig) % gsz); pn_ = (wgid % nig) / gsz;                                                      \
  } while (0)
#define FIRST_STAGES(pm_, pn_)                                                                                      \
  do {                                                                                                              \
    const u16* A_ = g.A + (g.a_pn_shift >= 0 ? (size_t)((pn_) >> g.a_pn_shift) * K : 0);                            \
    const u16* Bt_ = g.Bt + (g.b_pm_shift >= 0 ? (size_t)((pm_) >> g.b_pm_shift) * ((size_t)g.N * K) : 0);          \
    STAGE(SB(0, 0), Bt_, ldb, (pn_)*BM, 0); STAGE(SA(0, 0), A_, lda, (pm_)*BM, 0);                                  \
    STAGE(SB(0, 1), Bt_, ldb, (pn_)*BM + HALF, 0); STAGE(SA(0, 1), A_, lda, (pm_)*BM + HALF, 0);                    \
  } while (0)
  const int gstep = gdim();
  int tile = bidx(), pm = 0, pn = 0;
  if (tile < nwg) { TILE_COORDS(tile, pm, pn); FIRST_STAGES(pm, pn); }
  while (tile < nwg) {
    const int brow = pm * BM, bcol = pn * BM;
    const u16* __restrict__ A = g.A + (g.a_pn_shift >= 0 ? (size_t)(pn >> g.a_pn_shift) * K : 0);
    const u16* __restrict__ Bt = g.Bt + (g.b_pm_shift >= 0 ? (size_t)(pm >> g.b_pm_shift) * ((size_t)g.N * K) : 0);
    f32x4 acc[2][2][4][2] = {};
    bf16x8 At[4][2], B0[2][2], B1[2][2];
    if (wr == 1) BAR;
    WAIT_V(4); BAR;
    STAGE(SB(1, 0), Bt, ldb, bcol, 1); STAGE(SA(1, 0), A, lda, brow, 1); STAGE(SB(1, 1), Bt, ldb, bcol + HALF, 1);
    WAIT_V(6); BAR;
    for (int t = 0; t < nt - 2; t += 2) {
      LDB(B0, 0, 0); SCHED; LDA(At, 0, 0); STAGE(SA(1, 1), A, lda, brow + HALF, t + 1);
      WAIT_L(8); BAR; WAIT_L(0); MMA(0, 0, At, B0); BAR; SCHED;
      LDB(B1, 0, 1); STAGE(SB(0, 0), Bt, ldb, bcol, t + 2);
      BAR; WAIT_L(0); MMA(0, 1, At, B1); BAR;
      LDA(At, 0, 1); STAGE(SA(0, 0), A, lda, brow, t + 2);
      BAR; WAIT_L(0); MMA(1, 0, At, B0); BAR; SCHED;
      STAGE(SB(0, 1), Bt, ldb, bcol + HALF, t + 2);
      WAIT_V(6); BAR; MMA(1, 1, At, B1); BAR;
      LDB(B0, 1, 0); SCHED; LDA(At, 1, 0); STAGE(SA(0, 1), A, lda, brow + HALF, t + 2);
      WAIT_L(8); BAR; WAIT_L(0); MMA(0, 0, At, B0); BAR; SCHED;
      LDB(B1, 1, 1); STAGE(SB(1, 0), Bt, ldb, bcol, t + 3);
      BAR; WAIT_L(0); MMA(0, 1, At, B1); BAR;
      LDA(At, 1, 1); STAGE(SA(1, 0), A, lda, brow, t + 3);
      BAR; WAIT_L(0); MMA(1, 0, At, B0); BAR; SCHED;
      STAGE(SB(1, 1), Bt, ldb, bcol + HALF, t + 3);
      WAIT_V(6); BAR; MMA(1, 1, At, B1); BAR;
    }
    { LDB(B0, 0, 0); LDA(At, 0, 0); STAGE(SA(1, 1), A, lda, brow + HALF, nt - 1);
      BAR; WAIT_L(0); MMA(0, 0, At, B0); BAR;
      LDB(B1, 0, 1); BAR; WAIT_L(0); MMA(0, 1, At, B1); BAR;
      LDA(At, 0, 1); WAIT_V(4); BAR; WAIT_L(0); MMA(1, 0, At, B0); MMA(1, 1, At, B1); BAR; }
    { LDB(B0, 1, 0); LDA(At, 1, 0); WAIT_V(2); BAR; WAIT_L(0); MMA(0, 0, At, B0); BAR;
      LDB(B1, 1, 1); WAIT_V(0); BAR; WAIT_L(0); MMA(0, 1, At, B1); BAR;
      LDA(At, 1, 1); BAR; WAIT_L(0); MMA(1, 0, At, B0); MMA(1, 1, At, B1); BAR; }
    if (wr == 0) BAR;
    const int ntile = tile + gstep; int npm = 0, npn = 0;
    if (ntile < nwg) { TILE_COORDS(ntile, npm, npn); FIRST_STAGES(npm, npn); }
    {
      int t2 = threadIdx.x;
      asm volatile("" : "+v"(t2));
      const int wid2 = t2 >> 6, lane2 = t2 & 63, wr2 = wid2 >> 2, wc2 = wid2 & 3, fr2 = lane2 & 15, fq2 = lane2 >> 4;
      if constexpr (Epi::REGMODE) {
        epi.reg(acc, shmc + 65536, brow, pn, t2);
      } else {
      float* stg = (float*)(shmc + 65536);
      typename Epi::Pre pre[2];
      epi.pre(pre[0], brow, pn, wid2, lane2);
#pragma unroll
      for (int q = 0; q < 4; ++q) {
        if (q > 0) __syncthreads();
        if (wr2 == (q & 1)) {
#pragma unroll
          for (int m = 0; m < 4; ++m)
#pragma unroll
            for (int bj = 0; bj < 2; ++bj)
#pragma unroll
              for (int n = 0; n < 2; ++n)
                *(f32x4*)(stg + (m * 16 + fr2) * STG_LD + bj * 128 + wc2 * 32 + n * 16 + fq2 * 4) = acc[q >> 1][bj][m][n];
        }
        __syncthreads();
        if (q < 3) epi.pre(pre[(q + 1) & 1], brow + (q + 1) * 64, pn, wid2, lane2);
        epi(pre[q & 1], stg, brow + q * 64, pn, wid2, lane2);
      }
      }
    }
    __syncthreads();
    tile = ntile; pm = npm; pn = npn;
  }
#undef TILE_COORDS
#undef FIRST_STAGES
#undef SA
#undef SB
#undef STAGE
#undef LDA
#undef LDB
#undef MMA
}

typedef f32x4 AccT[2][2][4][2];
DI float row_rstd(const float* ssq, int row) {
  const f32x4 a = *(const f32x4*)(ssq + (size_t)row * 4);
  return rsqrtf(((a[0] + a[1]) + (a[2] + a[3])) * (1.f / 1024.f) + EPS_);
}
struct EpiStore {
  u16* O; int ldc; const float* ssq; int gelu_from;
  static constexpr bool REGMODE = true;
  DI void reg(const AccT& acc, char* lds, int brow, int pn, int t2) const {
    const int wid = t2 >> 6, lane = t2 & 63, wr = wid >> 2, wc = wid & 3, fr = lane & 15, fq = lane >> 4;
    u16* st = (u16*)lds;
    const bool dog = (pn * 256 >= gelu_from);
#pragma unroll
    for (int ai = 0; ai < 2; ++ai) {
      if (ai == 1) __syncthreads();
      f32x4 pq[4];
      if (ssq) {
#pragma unroll
        for (int m = 0; m < 4; ++m) pq[m] = *(const f32x4*)(ssq + (size_t)(brow + ai * 128 + wr * 64 + m * 16 + fr) * 4);
      }
#pragma unroll
      for (int m = 0; m < 4; ++m) {
        const int rl = wr * 64 + m * 16 + fr;
        const float rs = ssq ? rsqrtf(((pq[m][0] + pq[m][1]) + (pq[m][2] + pq[m][3])) * (1.f / 1024.f) + EPS_) : 1.f;
#pragma unroll
        for (int bj = 0; bj < 2; ++bj)
#pragma unroll
          for (int n = 0; n < 2; ++n) {
            f32x4 v = acc[ai][bj][m][n] * rs;
            if (dog) { v[0] = gelu_t(v[0]); v[1] = gelu_t(v[1]); v[2] = gelu_t(v[2]); v[3] = gelu_t(v[3]); }
            uint2 w; w.x = pack2(v[0], v[1]); w.y = pack2(v[2], v[3]);
            *(uint2*)(st + rl * 264 + bj * 128 + wc * 32 + n * 16 + fq * 4) = w;
          }
      }
      __syncthreads();
#pragma unroll
      for (int i = 0; i < 8; ++i) {
        const int c = t2 + 512 * i, row = c >> 5, seg = c & 31;
        const uint4 w = *(const uint4*)(st + row * 264 + seg * 8);
        *(uint4*)(O + (size_t)(brow + ai * 128 + row) * ldc + pn * 256 + seg * 8) = w;
      }
    }
  }
  struct Pre {};
  DI void pre(Pre&, int, int, int, int) const {}
  DI void operator()(const Pre&, const float* stg, int brow, int pn, int wv, int lane) const {
    const bool dog = (pn * 256 >= gelu_from);
#pragma unroll 4
    for (int rr = wv; rr < 64; rr += 8) {
      const int row = brow + rr;
      const float rs = ssq ? row_rstd(ssq, row) : 1.f;
      f32x4 v = *(const f32x4*)(stg + rr * STG_LD + lane * 4) * rs;
      if (dog) { v[0] = gelu_t(v[0]); v[1] = gelu_t(v[1]); v[2] = gelu_t(v[2]); v[3] = gelu_t(v[3]); }
      uint2 w; w.x = pack2(v[0], v[1]); w.y = pack2(v[2], v[3]);
      *(uint2*)(O + (size_t)row * ldc + pn * 256 + lane * 4) = w;
    }
  }
};

struct EpiMobaIn {
  u16* RAW; const float* ssq; const float* kgain; u16* KN; u16* VT; float* KMEAN;
  static constexpr bool REGMODE = true;
  struct Pre {};
  DI void pre(Pre&, int, int, int, int) const {}
  DI void operator()(const Pre&, const float*, int, int, int, int) const {}
  DI void reg(const AccT& acc, char* lds, int brow, int pn, int t2) const {
    const int wid = t2 >> 6, lane = t2 & 63, wr = wid >> 2, wc = wid & 3, fr = lane & 15, fq = lane >> 4;
    u16* st = (u16*)lds;
    float* red = (float*)(lds + 67584);
    const int b = brow >> 12, tloc = brow & (S_ - 1), nblk = tloc >> 8;
    float ksum = 0.f;
#pragma unroll
    for (int ai = 0; ai < 2; ++ai) {
      if (ai == 1) __syncthreads();
      f32x4 pq[4];
#pragma unroll
      for (int m = 0; m < 4; ++m) pq[m] = *(const f32x4*)(ssq + (size_t)(brow + ai * 128 + wr * 64 + m * 16 + fr) * 4);
#pragma unroll
      for (int m = 0; m < 4; ++m) {
        const int rl = wr * 64 + m * 16 + fr;
        const float rs = rsqrtf(((pq[m][0] + pq[m][1]) + (pq[m][2] + pq[m][3])) * (1.f / 1024.f) + EPS_);
#pragma unroll
        for (int bj = 0; bj < 2; ++bj)
#pragma unroll
          for (int n = 0; n < 2; ++n) {
            const f32x4 v = acc[ai][bj][m][n] * rs;
            uint2 w; w.x = pack2(v[0], v[1]); w.y = pack2(v[2], v[3]);
            *(uint2*)(st + rl * 264 + bj * 128 + wc * 32 + n * 16 + fq * 4) = w;
          }
      }
      __syncthreads();
      if (pn < 4) {
#pragma unroll
        for (int i = 0; i < 8; ++i) {
          const int c = t2 + 512 * i, row = c >> 5, seg = c & 31;
          const uint4 w = *(const uint4*)(st + row * 264 + seg * 8);
          *(uint4*)(RAW + (size_t)(brow + ai * 128 + row) * 3072 + pn * 256 + seg * 8) = w;
        }
      } else if (pn < 8) {
        const int seg = t2 & 31, d0 = (seg & 7) * 8;
        float gn[8], cs[8];
#pragma unroll
        for (int j = 0; j < 8; ++j) { gn[j] = kgain[d0 + j]; cs[j] = 0.f; }
#pragma unroll
        for (int i = 0; i < 8; ++i) {
          const int row = (t2 >> 5) + 16 * i;
          const uint4 w = *(const uint4*)(st + row * 264 + seg * 8);
          const unsigned uu[4] = {w.x, w.y, w.z, w.w};
          float v[8]; float ss = 0.f;
#pragma unroll
          for (int q = 0; q < 4; ++q) { v[2 * q] = bf2f((u16)(uu[q] & 0xffff)); v[2 * q + 1] = bf2f((u16)(uu[q] >> 16)); }
#pragma unroll
          for (int j = 0; j < 8; ++j) ss += v[j] * v[j];
          ss += __shfl_xor(ss, 1); ss += __shfl_xor(ss, 2); ss += __shfl_xor(ss, 4);
          const float r2 = rsqrtf(ss * (1.f / 64.f) + EPS_);
#pragma unroll
          for (int j = 0; j < 8; ++j) { v[j] = v[j] * r2 * gn[j]; cs[j] += v[j]; }
          uint4 o4; o4.x = pack2(v[0], v[1]); o4.y = pack2(v[2], v[3]); o4.z = pack2(v[4], v[5]); o4.w = pack2(v[6], v[7]);
          *(uint4*)(KN + (size_t)(brow + ai * 128 + row) * 1024 + (pn - 4) * 256 + seg * 8) = o4;
        }
#pragma unroll
        for (int j = 0; j < 8; ++j) cs[j] += __shfl_xor(cs[j], 32);
        if (lane < 32) {
#pragma unroll
          for (int j = 0; j < 8; ++j) red[wid * 256 + seg * 8 + j] = cs[j];
        }
        __syncthreads();
        if (t2 < 256) { float sm = 0.f;
#pragma unroll
          for (int w8 = 0; w8 < 8; ++w8) sm += red[w8 * 256 + t2];
          ksum += sm; }
      } else {
#pragma unroll
        for (int i = 0; i < 8; ++i) {
          const int item = t2 + 512 * i, rg = item & 15, col = item >> 4;
          unsigned uu[4];
#pragma unroll
          for (int q = 0; q < 4; ++q) uu[q] = (unsigned)st[(rg * 8 + 2 * q) * 264 + col] | ((unsigned)st[(rg * 8 + 2 * q + 1) * 264 + col] << 16);
          uint4 o4; o4.x = uu[0]; o4.y = uu[1]; o4.z = uu[2]; o4.w = uu[3];
          *(uint4*)(VT + (size_t)(b * 1024 + (pn - 8) * 256 + col) * S_ + tloc + ai * 128 + rg * 8) = o4;
        }
      }
    }
    if (pn >= 4 && pn < 8 && t2 < 256) KMEAN[((size_t)(b * 16 + (pn - 4) * 4 + (t2 >> 6)) * 16 + nblk) * 64 + (t2 & 63)] = ksum * (1.f / 256.f);
  }
};

struct EpiSwiglu {
  u16* O; const float* ssq;
  static constexpr bool REGMODE = true;
  DI void reg(const AccT& acc, char* lds, int brow, int pn, int t2) const {
    const int wid = t2 >> 6, lane = t2 & 63, wr = wid >> 2, wc = wid & 3, fr = lane & 15, fq = lane >> 4;
    u16* st = (u16*)lds;
    f32x4 pq[8];
#pragma unroll
    for (int q = 0; q < 8; ++q) pq[q] = *(const f32x4*)(ssq + (size_t)(brow + (q >> 2) * 128 + wr * 64 + (q & 3) * 16 + fr) * 4);
#pragma unroll
    for (int ai = 0; ai < 2; ++ai)
#pragma unroll
      for (int m = 0; m < 4; ++m) {
        const int rl = ai * 128 + wr * 64 + m * 16 + fr;
        const f32x4 q4 = pq[ai * 4 + m];
        const float rs = rsqrtf(((q4[0] + q4[1]) + (q4[2] + q4[3])) * (1.f / 1024.f) + EPS_);
#pragma unroll
        for (int n = 0; n < 2; ++n) {
          const f32x4 gt = acc[ai][0][m][n] * rs, up = acc[ai][1][m][n] * rs;
          f32x4 v;
#pragma unroll
          for (int j = 0; j < 4; ++j) v[j] = gt[j] * sigmoidf(gt[j]) * up[j];
          uint2 w; w.x = pack2(v[0], v[1]); w.y = pack2(v[2], v[3]);
          *(uint2*)(st + rl * 136 + wc * 32 + n * 16 + fq * 4) = w;
        }
      }
    __syncthreads();
#pragma unroll
    for (int i = 0; i < 8; ++i) {
      const int c = t2 + 512 * i, row = c >> 4, seg = c & 15;
      const uint4 w = *(const uint4*)(st + row * 136 + seg * 8);
      *(uint4*)(O + (size_t)(brow + row) * F_ + pn * 128 + seg * 8) = w;
    }
  }
  struct Pre {};
  DI void pre(Pre&, int, int, int, int) const {}
  DI void operator()(const Pre&, const float* stg, int brow, int pn, int wv, int lane) const {
    const int l32 = lane & 31;
#pragma unroll 4
    for (int rp = wv; rp < 32; rp += 8) {
      const int rr = rp * 2 + (lane >> 5), row = brow + rr;
      const float rs = row_rstd(ssq, row);
      const f32x4 gt = *(const f32x4*)(stg + rr * STG_LD + l32 * 4) * rs, up = *(const f32x4*)(stg + rr * STG_LD + 128 + l32 * 4) * rs;
      f32x4 v;
#pragma unroll
      for (int j = 0; j < 4; ++j) v[j] = gt[j] * sigmoidf(gt[j]) * up[j];
      uint2 w; w.x = pack2(v[0], v[1]); w.y = pack2(v[2], v[3]);
      *(uint2*)(O + (size_t)row * F_ + pn * 128 + l32 * 4) = w;
    }
  }
};

struct EpiResid {
  float* fout; u16* hb; float* ssq_next; float scale;
  static constexpr bool REGMODE = true;
  struct Pre {};
  DI void pre(Pre&, int, int, int, int) const {}
  DI void operator()(const Pre&, const float*, int, int, int, int) const {}
  DI void reg(const AccT& acc, char* lds, int brow, int pn, int t2) const {
    const int wid = t2 >> 6, lane = t2 & 63, wr = wid >> 2, wc = wid & 3, fr = lane & 15, fq = lane >> 4;
    u16* st = (u16*)lds;
#pragma unroll
    for (int ai = 0; ai < 2; ++ai) {
      if (ai == 1) __syncthreads();
      uint4 hq[8];
#pragma unroll
      for (int i = 0; i < 8; ++i) { const int c = t2 + 512 * i; hq[i] = *(const uint4*)(hb + (size_t)(brow + ai * 128 + (c >> 5)) * D_ + pn * 256 + (c & 31) * 8); }
#pragma unroll
      for (int m = 0; m < 4; ++m) {
        const int rl = wr * 64 + m * 16 + fr;
#pragma unroll
        for (int bj = 0; bj < 2; ++bj)
#pragma unroll
          for (int n = 0; n < 2; ++n) {
            const f32x4 v = acc[ai][bj][m][n] * scale;
            uint2 w; w.x = pack2(v[0], v[1]); w.y = pack2(v[2], v[3]);
            *(uint2*)(st + rl * 264 + bj * 128 + wc * 32 + n * 16 + fq * 4) = w;
          }
      }
      __syncthreads();
#pragma unroll
      for (int i = 0; i < 8; ++i) {
        const int c = t2 + 512 * i, row = c >> 5, seg = c & 31;
        const uint4 dw = *(const uint4*)(st + row * 264 + seg * 8);
        const unsigned du[4] = {dw.x, dw.y, dw.z, dw.w}, hu[4] = {hq[i].x, hq[i].y, hq[i].z, hq[i].w};
        float hv[8]; float sq = 0.f;
#pragma unroll
        for (int q = 0; q < 4; ++q) {
          hv[2 * q] = bf2f((u16)(hu[q] & 0xffff)) + bf2f((u16)(du[q] & 0xffff));
          hv[2 * q + 1] = bf2f((u16)(hu[q] >> 16)) + bf2f((u16)(du[q] >> 16));
          sq += hv[2 * q] * hv[2 * q] + hv[2 * q + 1] * hv[2 * q + 1];
        }
        const size_t idx = (size_t)(brow + ai * 128 + row) * D_ + pn * 256 + seg * 8;
        if (fout) { *(f32x4*)(fout + idx) = (f32x4){hv[0], hv[1], hv[2], hv[3]}; *(f32x4*)(fout + idx + 4) = (f32x4){hv[4], hv[5], hv[6], hv[7]}; }
        uint4 o4; o4.x = pack2(hv[0], hv[1]); o4.y = pack2(hv[2], hv[3]); o4.z = pack2(hv[4], hv[5]); o4.w = pack2(hv[6], hv[7]);
        *(uint4*)(hb + idx) = o4;
        if (ssq_next) {
          sq += __shfl_xor(sq, 1); sq += __shfl_xor(sq, 2); sq += __shfl_xor(sq, 4); sq += __shfl_xor(sq, 8); sq += __shfl_xor(sq, 16);
          if (seg == 0) ssq_next[(size_t)(brow + ai * 128 + row) * 4 + pn] = sq;
        }
      }
    }
  }
};

struct EpiLruGate {
  static constexpr bool REGMODE = false;
  DI void reg(const AccT&, char*, int, int, int) const {}
  const float* ba; const float* bx; const float* lam; const u16* xc; float* a; float* b;
  struct Pre {};
  DI void pre(Pre&, int, int, int, int) const {}
  DI void operator()(const Pre&, const float* stg, int brow, int pn, int wv, int lane) const {
    const int l32 = lane & 31;
    const int ch = (pn >> 1) * 256 + (pn & 1) * 128 + l32 * 4;
    const f32x4 vba = *(const f32x4*)(ba + ch), vbx = *(const f32x4*)(bx + ch), vl = *(const f32x4*)(lam + ch);
    f32x4 sp;
#pragma unroll
    for (int j = 0; j < 4; ++j) sp[j] = __logf(1.f + __expf(-vl[j]));
#pragma unroll 2
    for (int rp = wv; rp < 32; rp += 8) {
      const int rr = rp * 2 + (lane >> 5), row = brow + rr;
      const size_t idx = (size_t)row * D_ + ch;
      const uint2 xw = *(const uint2*)(xc + idx);
      const float xv[4] = {bf2f((u16)(xw.x & 0xffff)), bf2f((u16)(xw.x >> 16)), bf2f((u16)(xw.y & 0xffff)), bf2f((u16)(xw.y >> 16))};
      const f32x4 ra = *(const f32x4*)(stg + rr * STG_LD + l32 * 4), ia = *(const f32x4*)(stg + rr * STG_LD + 128 + l32 * 4);
      f32x4 av, bv;
#pragma unroll
      for (int j = 0; j < 4; ++j) {
        const float r = sigmoidf(ra[j] + vba[j]), ig = sigmoidf(ia[j] + vbx[j]);
        const float la = -8.f * r * sp[j];
        const float x2 = 2.f * la;
        float mult = sqrtf((x2 > -0.05f) ? -x2 * (1.f + x2 * (0.5f + x2 * (0.16666667f + x2 * 0.041666667f))) : 1.f - __expf(x2));
        if ((row & (S_ - 1)) == 0) mult = 1.f;
        av[j] = __expf(la); bv[j] = mult * ig * xv[j];
      }
      *(f32x4*)(a + idx) = av; *(f32x4*)(b + idx) = bv;
    }
  }
};

constexpr int KLD = 72;
#define MFMA32(a, b, c) __builtin_amdgcn_mfma_f32_32x32x16_bf16((a), (b), (c), 0, 0, 0)

DI int keyoff(int sb, int i, int hf) { return sb * 32 + (i >> 2) * 8 + hf * 4 + (i & 3); }

DI void qk_scores(const u16* Ks, const bf16x8 (&qf)[4], int lane, f32x16 (&s)[2]) {
  const int r = lane & 31, hf = lane >> 5;
#pragma unroll
  for (int sb = 0; sb < 2; ++sb) {
    f32x16 acc = {};
#pragma unroll
    for (int st = 0; st < 4; ++st) {
      const bf16x8 a = *(const bf16x8*)(Ks + (sb * 32 + r) * KLD + st * 16 + hf * 8);
      acc = MFMA32(a, qf[st], acc);
    }
    s[sb] = acc;
  }
}

DI void pv_acc(const u16* Vs, const f32x16 (&p)[2], f32x16 (&o)[2], int lane) {
  const int r = lane & 31, hf = lane >> 5;
#pragma unroll
  for (int sb = 0; sb < 2; ++sb)
#pragma unroll
    for (int c = 0; c < 2; ++c) {
      union { bf16x8 v; unsigned u[4]; } pb;
#pragma unroll
      for (int q = 0; q < 4; ++q) pb.u[q] = pack2(p[sb][8 * c + 2 * q], p[sb][8 * c + 2 * q + 1]);
#pragma unroll
      for (int db = 0; db < 2; ++db) {
        const u16* vp = Vs + (db * 32 + r) * KLD + sb * 32 + c * 16 + hf * 4;
        union { bf16x8 v; s16x4 h[2]; } a;
        a.h[0] = *(const s16x4*)(vp); a.h[1] = *(const s16x4*)(vp + 8);
        o[db] = MFMA32(a.v, pb.v, o[db]);
      }
    }
}

template <class VF>
DI void softmax_pv(const u16* Vs, f32x16 (&s)[2], float& m, float& l, f32x16 (&o)[2], int lane, VF validf) {
  const int hf = lane >> 5;
  float ls = 0.f;
#pragma unroll
  for (int sb = 0; sb < 2; ++sb)
#pragma unroll
    for (int i = 0; i < 16; ++i) { const float pv = validf(keyoff(sb, i, hf)) ? __builtin_amdgcn_exp2f(s[sb][i]) : 0.f; s[sb][i] = pv; ls += pv; }
  l += ls;
  pv_acc(Vs, s, o, lane);
}

DI void softmax_pv_lane(const u16* Vs, f32x16 (&s)[2], float& m, float& l, f32x16 (&o)[2], int lane, bool lv) {
  const float me = lv ? 0.f : 1e30f;
  float ls = 0.f;
#pragma unroll
  for (int sb = 0; sb < 2; ++sb)
#pragma unroll
    for (int i = 0; i < 16; ++i) { const float pv = __builtin_amdgcn_exp2f(s[sb][i] - me); s[sb][i] = pv; ls += pv; }
  l += ls;
  pv_acc(Vs, s, o, lane);
}

DI void prob_lane(f32x16 (&s)[2], float& l, bool lv) {
  const float me = lv ? 0.f : 1e30f;
  float ls = 0.f;
#pragma unroll
  for (int sb = 0; sb < 2; ++sb)
#pragma unroll
    for (int i = 0; i < 16; ++i) { const float pv = __builtin_amdgcn_exp2f(s[sb][i] - me); s[sb][i] = pv; ls += pv; }
  l += ls;
}
template <class VF>
DI void prob_elem(f32x16 (&s)[2], float& l, int lane, VF validf) {
  const int hf = lane >> 5;
  float ls = 0.f;
#pragma unroll
  for (int sb = 0; sb < 2; ++sb)
#pragma unroll
    for (int i = 0; i < 16; ++i) { const float pv = validf(keyoff(sb, i, hf)) ? __builtin_amdgcn_exp2f(s[sb][i]) : 0.f; s[sb][i] = pv; ls += pv; }
  l += ls;
}

DI void kv_load(int tid, const u16* kb, int kld, const u16* vb, int vld, int key0, uint4& kr, uint4& vr) {
  const int r = tid >> 3, seg = tid & 7;
  kr = *(const uint4*)(kb + (size_t)(key0 + r) * kld + seg * 8);
  vr = *(const uint4*)(vb + (size_t)r * vld + key0 + seg * 8);
}
DI void kv_store(int tid, u16* Ks, u16* Vs, const uint4& kr, const uint4& vr) {
  const int r = tid >> 3, seg = tid & 7;
  *(uint4*)(Ks + r * KLD + seg * 8) = kr;
  *(uint4*)(Vs + r * KLD + seg * 8) = vr;
}

template <class TF>
DI void attn_loop(int tid, const int* list, int cnt, const u16* kb, int kld, const u16* vb, int vld, u16* Ks, u16* Vs, TF f) {
  constexpr int BUFO = 2 * 64 * KLD;
  uint4 k0r, v0r, k1r, v1r;
  if (cnt > 0) kv_load(tid, kb, kld, vb, vld, list[0], k0r, v0r);
  if (cnt > 1) kv_load(tid, kb, kld, vb, vld, list[1], k1r, v1r);
  if (cnt > 0) kv_store(tid, Ks, Vs, k0r, v0r);
  __syncthreads();
  for (int it = 0; it < cnt; it += 2) {
    if (it + 2 < cnt) kv_load(tid, kb, kld, vb, vld, list[it + 2], k0r, v0r);
    f(list[it], Ks, Vs);
    if (it + 1 < cnt) kv_store(tid, Ks + BUFO, Vs + BUFO, k1r, v1r);
    __syncthreads();
    if (it + 1 < cnt) {
      if (it + 3 < cnt) kv_load(tid, kb, kld, vb, vld, list[it + 3], k1r, v1r);
      f(list[it + 1], Ks + BUFO, Vs + BUFO);
      if (it + 2 < cnt) kv_store(tid, Ks, Vs, k0r, v0r);
      __syncthreads();
    }
  }
}

template <class TF>
DI void attn_loop_p2(int tid, const int* list, int cnt, const u16* kb, int kld, const u16* vb, int vld, u16* Ks, TF f) {
  constexpr int BUFO = 2 * 64 * KLD;
  if (cnt <= 0) return;
  uint4 k0r, v0r, k1r, v1r;
  kv_load(tid, kb, kld, vb, vld, list[0], k0r, v0r);
  kv_load(tid, kb, kld, vb, vld, list[1], k1r, v1r);
  kv_store(tid, Ks, Ks + 64 * KLD, k0r, v0r);
  kv_store(tid, Ks + BUFO, Ks + BUFO + 64 * KLD, k1r, v1r);
  __syncthreads();
  for (int it = 0; it < cnt; it += 2) {
    const int base = ((it >> 1) & 1) * 2;
    u16* Ka = Ks + base * BUFO; u16* Kb = Ka + BUFO;
    u16* Na = Ks + (2 - base) * BUFO; u16* Nb = Na + BUFO;
    if (it + 2 < cnt) { kv_load(tid, kb, kld, vb, vld, list[it + 2], k0r, v0r); kv_load(tid, kb, kld, vb, vld, list[it + 3], k1r, v1r); }
    f(list[it], Ka, Ka + 64 * KLD);
    f(list[it + 1], Kb, Kb + 64 * KLD);
    if (it + 2 < cnt) { kv_store(tid, Na, Na + 64 * KLD, k0r, v0r); kv_store(tid, Nb, Nb + 64 * KLD, k1r, v1r); }
    __syncthreads();
  }
}

template <bool keep>
DI void load_q(const u16* qrow, const float* gain, float scale, int lane, bf16x8 (&qf)[4], float (&qn)[32]) {
  const int hf = lane >> 5;
  float v[32]; float ss = 0.f;
#pragma unroll
  for (int st = 0; st < 4; ++st) {
    const uint4 w = *(const uint4*)(qrow + st * 16 + hf * 8);
    const unsigned uu[4] = {w.x, w.y, w.z, w.w};
#pragma unroll
    for (int q = 0; q < 4; ++q) { v[st * 8 + 2 * q] = bf2f((u16)(uu[q] & 0xffff)); v[st * 8 + 2 * q + 1] = bf2f((u16)(uu[q] >> 16)); }
  }
#pragma unroll
  for (int i = 0; i < 32; ++i) ss += v[i] * v[i];
  ss += __shfl_xor(ss, 32);
  const float rs = rsqrtf(ss * (1.f / 64.f) + EPS_);
#pragma unroll
  for (int st = 0; st < 4; ++st) {
    union { bf16x8 v8; unsigned u[4]; } pk;
#pragma unroll
    for (int q = 0; q < 4; ++q) {
      const int d0 = st * 16 + hf * 8 + 2 * q;
      const float a = v[st * 8 + 2 * q] * rs * gain[d0], b = v[st * 8 + 2 * q + 1] * rs * gain[d0 + 1];
      if (keep) { qn[st * 8 + 2 * q] = a; qn[st * 8 + 2 * q + 1] = b; }
      pk.u[q] = pack2(a * scale, b * scale);
    }
    qf[st] = pk.v8;
  }
}

DI void acc_out(f32x16 (&tot)[2], const f32x16 (&o)[2], float w) {
#pragma unroll
  for (int db = 0; db < 2; ++db) tot[db] = tot[db] + o[db] * w;
}
DI void store_out(u16* orow, const f32x16 (&tot)[2], int lane) {
  const int hf = lane >> 5;
#pragma unroll
  for (int db = 0; db < 2; ++db)
#pragma unroll
    for (int gq = 0; gq < 4; ++gq) {
      uint2 w; w.x = pack2(tot[db][gq * 4 + 0], tot[db][gq * 4 + 1]); w.y = pack2(tot[db][gq * 4 + 2], tot[db][gq * 4 + 3]);
      *(uint2*)(orow + db * 32 + gq * 8 + hf * 4) = w;
    }
}

DI void moba_prep(const u16* RAW, const float* kgain, u16* KN, u16* VT, float* KMEAN, char* shm) {
  float* tile = (float*)shm;
  float* part = tile + 256 * 65;
  const int tid = tidx();
  for (int item = bidx(); item < 1024; item += gdim()) {
    const int h = item & 15, n = (item >> 4) & 15, b = item >> 8;
    const int t0 = b * S_ + n * 256;
    {
      const int tk = tid >> 1, half = tid & 1;
      const u16* src = RAW + (size_t)(t0 + tk) * 3072 + 1024 + h * 64 + half * 32;
      float v[32]; float ss = 0.f;
#pragma unroll
      for (int q4 = 0; q4 < 4; ++q4) {
        const uint4 w = *(const uint4*)(src + q4 * 8);
        const unsigned uu[4] = {w.x, w.y, w.z, w.w};
#pragma unroll
        for (int q = 0; q < 4; ++q) { v[q4 * 8 + 2 * q] = bf2f((u16)(uu[q] & 0xffff)); v[q4 * 8 + 2 * q + 1] = bf2f((u16)(uu[q] >> 16)); }
      }
#pragma unroll
      for (int i = 0; i < 32; ++i) ss += v[i] * v[i];
      ss += __shfl_xor(ss, 1);
      const float rs = rsqrtf(ss * (1.f / 64.f) + EPS_);
      u16* dst = KN + (size_t)(t0 + tk) * 1024 + h * 64 + half * 32;
#pragma unroll
      for (int q4 = 0; q4 < 4; ++q4) {
        uint4 w; unsigned uu[4];
#pragma unroll
        for (int q = 0; q < 4; ++q) {
          const int d = half * 32 + q4 * 8 + 2 * q;
          const float a = v[q4 * 8 + 2 * q] * rs * kgain[d], bb = v[q4 * 8 + 2 * q + 1] * rs * kgain[d + 1];
          tile[tk * 65 + d] = a; tile[tk * 65 + d + 1] = bb;
          uu[q] = pack2(a, bb);
        }
        w.x = uu[0]; w.y = uu[1]; w.z = uu[2]; w.w = uu[3];
        *(uint4*)(dst + q4 * 8) = w;
      }
    }
    __syncthreads();
    { const int d = tid & 63, pt = tid >> 6; float s = 0.f;
      for (int i = 0; i < 32; ++i) s += tile[(pt * 32 + i) * 65 + d];
      part[pt * 64 + d] = s; }
    __syncthreads();
    if (tid < 64) { float s = 0.f; for (int i = 0; i < 8; ++i) s += part[i * 64 + tid];
      KMEAN[((size_t)(b * 16 + h) * 16 + n) * 64 + tid] = s * (1.f / 256.f); }
    __syncthreads();
    {
      u16* vt = (u16*)shm;
      const int tk = tid >> 1, half = tid & 1;
      const u16* src = RAW + (size_t)(t0 + tk) * 3072 + 2048 + h * 64 + half * 32;
#pragma unroll
      for (int q4 = 0; q4 < 4; ++q4) {
        const uint4 w = *(const uint4*)(src + q4 * 8);
        unsigned* dp = (unsigned*)(vt + tk * 66 + half * 32 + q4 * 8);
        dp[0] = w.x; dp[1] = w.y; dp[2] = w.z; dp[3] = w.w;
      }
      __syncthreads();
      const int d = tid >> 3, ts = (tid & 7) * 32;
      u16* dst = VT + ((size_t)(b * 1024 + h * 64 + d)) * S_ + n * 256 + ts;
#pragma unroll
      for (int q4 = 0; q4 < 4; ++q4) {
        uint4 w; unsigned uu[4];
#pragma unroll
        for (int q = 0; q < 4; ++q) uu[q] = (unsigned)vt[(ts + q4 * 8 + 2 * q) * 66 + d] | ((unsigned)vt[(ts + q4 * 8 + 2 * q + 1) * 66 + d] << 16);
        w.x = uu[0]; w.y = uu[1]; w.z = uu[2]; w.w = uu[3];
        *(uint4*)(dst + q4 * 8) = w;
      }
    }
    __syncthreads();
  }
}

DI void moba_attn(const u16* RAW, const float* qgain, const u16* KN, const u16* VT, const float* KMEAN, u16* O, char* shm) {
  u16* Ks = (u16*)shm; u16* Vs = Ks + 64 * KLD;
  float* km = (float*)(Ks + 8 * 64 * KLD);
  int* list = (int*)(km + 16 * 64);
  int* misc = list + 64;
  const int tid = tidx(), wv = tid >> 6, lane = tid & 63, r = lane & 31, hf = lane >> 5;
  for (int it0 = bidx(); it0 < 1024; it0 += gdim()) {
    const int rnd = it0 >> 8, idx = it0 & 255, grp = idx >> 6, sub = idx & 63;
    const int own = (rnd == 0) ? 15 - grp : (rnd == 1) ? 8 + grp : (rnd == 2) ? 7 - grp : grp;
    const int b = sub >> 4, h = sub & 15;
    const int pos = own * 256 + wv * 32 + r;
    const size_t tok = (size_t)b * S_ + pos;
    for (int i = tid; i < 1024; i += 512) km[i] = KMEAN[(size_t)(b * 16 + h) * 1024 + i];
    if (tid == 0) misc[0] = 0;
    bf16x8 qf[4]; float qn[32];
    load_q<true>(RAW + tok * 3072 + h * 64, qgain, 0.125f * LOG2E, lane, qf, qn);
    __syncthreads();
    float v0 = -3e38f, v1 = -3e38f, v2 = -3e38f; int i0 = -1, i1 = -1, i2 = -1;
    for (int n = 0; n < own; ++n) {
      float gsum = 0.f;
#pragma unroll
      for (int st = 0; st < 4; ++st)
#pragma unroll
        for (int j = 0; j < 8; ++j) gsum += qn[st * 8 + j] * km[n * 64 + st * 16 + hf * 8 + j];
      gsum += __shfl_xor(gsum, 32);
      if (gsum > v0) { v2 = v1; i2 = i1; v1 = v0; i1 = i0; v0 = gsum; i0 = n; }
      else if (gsum > v1) { v2 = v1; i2 = i1; v1 = gsum; i1 = n; }
      else if (gsum > v2) { v2 = gsum; i2 = n; }
    }
    unsigned mymask = 0;
    if (i0 >= 0) mymask |= 1u << i0;
    if (i1 >= 0) mymask |= 1u << i1;
    if (i2 >= 0) mymask |= 1u << i2;
    unsigned wor = mymask;
#pragma unroll
    for (int o = 1; o < 64; o <<= 1) wor |= (unsigned)__shfl_xor((int)wor, o);
    if (lane == 0) atomicOr((unsigned*)&misc[0], wor);
    __syncthreads();
    if (tid == 0) {
      const unsigned un = (unsigned)misc[0]; int c = 0;
      for (int n = 0; n <= own; ++n) if (n == own || ((un >> n) & 1)) for (int kt = 0; kt < 4; ++kt) list[c++] = n * 256 + kt * 64;
      misc[1] = c;
    }
    __syncthreads();
    const int cnt = misc[1];
    f32x16 o[2] = {}; float m = -1e30f, l = 0.f;
    const int wmax = own * 256 + wv * 32 + 31;
    attn_loop_p2(tid, list, cnt, KN + (size_t)b * S_ * 1024 + h * 64, 1024, VT + (size_t)(b * 1024 + h * 64) * S_, S_, Ks, [&](int key0, const u16* Ks, const u16* Vs) {
      const int n = key0 >> 8;
      const bool need = (n == own) ? (key0 <= wmax) : ((wor >> n) & 1);
      if (need) {
        f32x16 s[2];
        qk_scores(Ks, qf, lane, s);
        if (n != own) prob_lane(s, l, (mymask >> n) & 1);
        else if (key0 + 63 <= wmax - 31) prob_lane(s, l, true);
        else prob_elem(s, l, lane, [&](int ko) { return key0 + ko <= pos; });
        pv_acc(Vs, s, o, lane);
      }
    });
    l += __shfl_xor(l, 32);
    f32x16 tot[2] = {};
    acc_out(tot, o, 1.f / l);
    store_out(O + tok * 1024 + h * 64, tot, lane);
  }
}

DI void lru_conv(const u16* RAW, const float* cw, const float* cb, u16* XC) {
  const int nth = gdim() * 512;
  for (int i = bidx() * 512 + tidx(); i < T_ * 128; i += nth) {
    const int t = i >> 7, c0 = (i & 127) * 8, ts = t & (S_ - 1);
    float acc[8];
#pragma unroll
    for (int j = 0; j < 8; ++j) acc[j] = cb[c0 + j];
#pragma unroll
    for (int k = 0; k < 4; ++k) {
      if (ts - 3 + k >= 0) {
        const uint4 w = *(const uint4*)(RAW + (size_t)(t - 3 + k) * 2048 + c0);
        const unsigned uu[4] = {w.x, w.y, w.z, w.w};
#pragma unroll
        for (int q = 0; q < 4; ++q) {
          acc[2 * q] += cw[k * 1024 + c0 + 2 * q] * bf2f((u16)(uu[q] & 0xffff));
          acc[2 * q + 1] += cw[k * 1024 + c0 + 2 * q + 1] * bf2f((u16)(uu[q] >> 16));
        }
      }
    }
    uint4 w; w.x = pack2(acc[0], acc[1]); w.y = pack2(acc[2], acc[3]); w.z = pack2(acc[4], acc[5]); w.w = pack2(acc[6], acc[7]);
    *(uint4*)(XC + (size_t)t * 1024 + c0) = w;
  }
}

DI void lru_scan1(const float* A, const float* Bv, float* PC, float* HC) {
  const int tid = tidx();
  for (int vb = bidx(); vb < 256; vb += gdim()) {
    const int gi = vb * 512 + tid, cg = gi & 255, c = (gi >> 8) & 127, b = gi >> 15;
    const size_t base = ((size_t)b * S_ + c * 32) * 1024 + cg * 4;
    f32x4 hl = {0.f, 0.f, 0.f, 0.f}, P = {1.f, 1.f, 1.f, 1.f};
#pragma unroll 8
    for (int i = 0; i < 32; ++i) { const f32x4 a = *(const f32x4*)(A + base + (size_t)i * 1024), bb = *(const f32x4*)(Bv + base + (size_t)i * 1024); hl = a * hl + bb; P = P * a; }
    const size_t q = ((size_t)(b * 128 + c)) * 1024 + cg * 4;
    *(f32x4*)(PC + q) = P; *(f32x4*)(HC + q) = hl;
  }
}
DI void lru_scan2(const float* A, const float* Bv, const float* PC, const float* HC, const u16* RAW, u16* HY) {
  const int tid = tidx();
  for (int vb = bidx(); vb < 256; vb += gdim()) {
    const int gi = vb * 512 + tid, cg = gi & 255, c = (gi >> 8) & 127, b = gi >> 15;
    f32x4 h = {0.f, 0.f, 0.f, 0.f};
    {
      int cc = 0;
      for (; cc + 8 <= c; cc += 8) {
        f32x4 Pv[8], Hv[8];
#pragma unroll
        for (int u = 0; u < 8; ++u) { const size_t q = ((size_t)(b * 128 + cc + u)) * 1024 + cg * 4; Pv[u] = *(const f32x4*)(PC + q); Hv[u] = *(const f32x4*)(HC + q); }
#pragma unroll
        for (int u = 0; u < 8; ++u) h = Pv[u] * h + Hv[u];
      }
      for (; cc < c; ++cc) { const size_t q = ((size_t)(b * 128 + cc)) * 1024 + cg * 4; h = *(const f32x4*)(PC + q) * h + *(const f32x4*)(HC + q); }
    }
    const size_t t0 = (size_t)b * S_ + c * 32;
#pragma unroll 8
    for (int i = 0; i < 32; ++i) {
      const size_t t = t0 + i;
      h = *(const f32x4*)(A + t * 1024 + cg * 4) * h + *(const f32x4*)(Bv + t * 1024 + cg * 4);
      const uint2 yw = *(const uint2*)(RAW + t * 2048 + 1024 + cg * 4);
      uint2 w;
      w.x = pack2(h[0] * bf2f((u16)(yw.x & 0xffff)), h[1] * bf2f((u16)(yw.x >> 16)));
      w.y = pack2(h[2] * bf2f((u16)(yw.y & 0xffff)), h[3] * bf2f((u16)(yw.y >> 16)));
      *(uint2*)(HY + t * 1024 + cg * 4) = w;
    }
  }
}

DI void nsa_prep(const u16* RAW, const Params& p, char* scr, char* shm, int mode, int vbid, int vnb) {
  const int tid = tidx();
  const float* gate_b = p.in[20]; const float* ksg = p.in[23]; const float* kwg = p.in[24];
  const float* pos_k = p.in[25]; const float* pos_v = p.in[26];
  u16* KSN = (u16*)(scr + N_KSN); u16* KWN = (u16*)(scr + N_KWN); u16* VST = (u16*)(scr + N_VST); u16* VWT = (u16*)(scr + N_VWT);
  u16* AK = (u16*)(scr + N_AK); u16* AV = (u16*)(scr + N_AV); float* GATES = (float*)(scr + N_GATES);
  if (mode == 2)
  for (int item = vbid; item < 512; item += vnb) {
    const int which = item & 1, g = (item >> 1) & 3, n = (item >> 3) & 15, b = item >> 7;
    const int t0 = b * S_ + n * 256;
    const int kcol = (which ? 2048 : 1536) + g * 64, vcol = (which ? 2304 : 1792) + g * 64;
    const float* gain = which ? kwg : ksg;
    u16* KNo = which ? KWN : KSN; u16* VTo = which ? VWT : VST;
    {
      const int tk = tid >> 1, half = tid & 1;
      const u16* src = RAW + (size_t)(t0 + tk) * 2816 + kcol + half * 32;
      float v[32]; float ss = 0.f;
#pragma unroll
      for (int q4 = 0; q4 < 4; ++q4) {
        const uint4 w = *(const uint4*)(src + q4 * 8);
        const unsigned uu[4] = {w.x, w.y, w.z, w.w};
#pragma unroll
        for (int q = 0; q < 4; ++q) { v[q4 * 8 + 2 * q] = bf2f((u16)(uu[q] & 0xffff)); v[q4 * 8 + 2 * q + 1] = bf2f((u16)(uu[q] >> 16)); }
      }
#pragma unroll
      for (int i = 0; i < 32; ++i) ss += v[i] * v[i];
      ss += __shfl_xor(ss, 1);
      const float rs = rsqrtf(ss * (1.f / 64.f) + EPS_);
      u16* dst = KNo + (size_t)(t0 + tk) * 256 + g * 64 + half * 32;
#pragma unroll
      for (int q4 = 0; q4 < 4; ++q4) {
        unsigned uu[4];
#pragma unroll
        for (int q = 0; q < 4; ++q) { const int d = half * 32 + q4 * 8 + 2 * q; uu[q] = pack2(v[q4 * 8 + 2 * q] * rs * gain[d], v[q4 * 8 + 2 * q + 1] * rs * gain[d + 1]); }
        uint4 w; w.x = uu[0]; w.y = uu[1]; w.z = uu[2]; w.w = uu[3];
        *(uint4*)(dst + q4 * 8) = w;
      }
    }
    {
      u16* vt = (u16*)shm;
      const int tk = tid >> 1, half = tid & 1;
      const u16* src = RAW + (size_t)(t0 + tk) * 2816 + vcol + half * 32;
#pragma unroll
      for (int q4 = 0; q4 < 4; ++q4) {
        const uint4 w = *(const uint4*)(src + q4 * 8);
        unsigned* dp = (unsigned*)(vt + tk * 66 + half * 32 + q4 * 8);
        dp[0] = w.x; dp[1] = w.y; dp[2] = w.z; dp[3] = w.w;
      }
      __syncthreads();
      const int d = tid >> 3, ts = (tid & 7) * 32;
      u16* dst = VTo + ((size_t)(b * 256 + g * 64 + d)) * S_ + n * 256 + ts;
#pragma unroll
      for (int q4 = 0; q4 < 4; ++q4) {
        unsigned uu[4];
#pragma unroll
        for (int q = 0; q < 4; ++q) uu[q] = (unsigned)vt[(ts + q4 * 8 + 2 * q) * 66 + d] | ((unsigned)vt[(ts + q4 * 8 + 2 * q + 1) * 66 + d] << 16);
        uint4 w; w.x = uu[0]; w.y = uu[1]; w.z = uu[2]; w.w = uu[3];
        *(uint4*)(dst + q4 * 8) = w;
      }
      __syncthreads();
    }
  }
  const int nth = vnb * 512, gt = vbid * 512 + tid;
  if (mode == 2)
  for (int i = gt; i < T_ * 48; i += nth) {
    const int t = i / 48, c = i - t * 48;
    GATES[i] = sigmoidf(bf2f(RAW[(size_t)t * 2816 + 2560 + c]) + gate_b[c]);
  }
  if (mode == 1)
  for (int i = gt; i < 4096 * 256; i += nth) {
    const int row = i >> 8, c8 = (i & 255) * 8, ii = c8 >> 6, d = c8 & 63;
    const int n = row & 255, g = (row >> 8) & 3, b = row >> 10;
    uint4 wk = make_uint4(0, 0, 0, 0), wv = wk;
    if (n < 255) {
      const size_t t = (size_t)b * S_ + n * 16 + ii;
      const uint4 rk = *(const uint4*)(RAW + t * 2816 + 1024 + g * 64 + d);
      const uint4 rv = *(const uint4*)(RAW + t * 2816 + 1280 + g * 64 + d);
      const unsigned ku[4] = {rk.x, rk.y, rk.z, rk.w}, vu[4] = {rv.x, rv.y, rv.z, rv.w};
      unsigned ko[4], vo[4];
#pragma unroll
      for (int q = 0; q < 4; ++q) {
        const int e = ii * 64 + d + 2 * q;
        ko[q] = pack2(bf2f((u16)(ku[q] & 0xffff)) + pos_k[e], bf2f((u16)(ku[q] >> 16)) + pos_k[e + 1]);
        vo[q] = pack2(bf2f((u16)(vu[q] & 0xffff)) + pos_v[e], bf2f((u16)(vu[q] >> 16)) + pos_v[e + 1]);
      }
      wk = make_uint4(ko[0], ko[1], ko[2], ko[3]); wv = make_uint4(vo[0], vo[1], vo[2], vo[3]);
    }
    *(uint4*)(AK + (size_t)row * 2048 + c8) = wk;
    *(uint4*)(AV + (size_t)row * 2048 + c8) = wv;
  }
}

DI void nsa_cmp2(const u16* HK, const u16* HV, const float* w2k, const float* w2v, const float* kcg, u16* KCMP, u16* VCMPT) {
  const int tid = tidx(); const int wv = tid >> 6, lane = tid & 63;
  for (int rw = bidx() * 8 + wv; rw < 8192; rw += gdim() * 8) {
    const int which = rw >> 12, row = rw & 4095;
    const u16* hrow = (which ? HV : HK) + (size_t)row * 256;
    const float* w2 = which ? w2v : w2k;
    float acc = 0.f;
#pragma unroll 4
    for (int k0 = 0; k0 < 256; k0 += 8) {
      const uint4 hw = *(const uint4*)(hrow + k0);
      const unsigned uu[4] = {hw.x, hw.y, hw.z, hw.w};
#pragma unroll
      for (int u = 0; u < 4; ++u) {
        acc += bf2f((u16)(uu[u] & 0xffff)) * w2[(k0 + 2 * u) * 64 + lane];
        acc += bf2f((u16)(uu[u] >> 16)) * w2[(k0 + 2 * u + 1) * 64 + lane];
      }
    }
    if (which == 0) {
      float ss = acc * acc;
#pragma unroll
      for (int o = 1; o < 64; o <<= 1) ss += __shfl_xor(ss, o);
      const float rs = rsqrtf(ss * (1.f / 64.f) + EPS_);
      KCMP[(size_t)row * 64 + lane] = f2bf(acc * rs * kcg[lane]);
    } else {
      const int bg = row >> 8, n = row & 255;
      VCMPT[((size_t)bg * 64 + lane) * 256 + n] = f2bf(acc);
    }
  }
}

DI void nsa_attn(const u16* RAW, const Params& p, char* scr, char* shm) {
  const u16* KSN = (const u16*)(scr + N_KSN); const u16* KWN = (const u16*)(scr + N_KWN);
  const u16* VST = (const u16*)(scr + N_VST); const u16* VWT = (const u16*)(scr + N_VWT);
  const u16* KCMP = (const u16*)(scr + N_KCMP); const u16* VCMPT = (const u16*)(scr + N_VCMPT);
  const float* GATES = (const float*)(scr + N_GATES); u16* O = (u16*)(scr + N_O);
  const float* qgain = p.in[21];
  u16* Ks = (u16*)shm; u16* Vs = Ks + 64 * KLD;
  int* list = (int*)(Ks + 4 * 64 * KLD);
  unsigned* selm = (unsigned*)(list + 64);
  unsigned* misc = selm + 128;
  float* invs = (float*)(misc + 4);
  float* totl = invs + 256;
  float* impH = totl;
  const int tid = tidx(), wv = tid >> 6, lane = tid & 63, r = lane & 31, hf = lane >> 5;
  const int hh = wv & 3, qh = wv >> 2;
  for (int it0 = bidx(); it0 < 1024; it0 += gdim()) {
    const int rnd = it0 >> 8, idx = it0 & 255, sub = idx & 15, ci = idx >> 4;
    const int c = (rnd == 0) ? 63 - ci : (rnd == 1) ? 32 + ci : (rnd == 2) ? 31 - ci : ci;
    const int b = sub >> 2, g = sub & 3, h = g * 4 + hh;
    const int ql = qh * 32 + r;
    const int pos = c * 64 + ql;
    const size_t tok = (size_t)b * S_ + pos;
    bf16x8 qf[4]; float qn[32];
    load_q<false>(RAW + tok * 2816 + h * 64, qgain, 0.125f * LOG2E, lane, qf, qn);
    for (int i = tid; i < 4 * 64 * 65; i += 512) impH[i] = 0.f;
    const int ncmp = min(255, 4 * c + 3);
    const int ntile = (ncmp + 63) >> 6;
    if (tid < 64) list[tid] = tid * 64;
    __syncthreads();
    const u16* kcb = KCMP + (size_t)(b * 4 + g) * 256 * 64;
    const u16* vcb = VCMPT + (size_t)(b * 4 + g) * 64 * 256;
    float l = 0.f;
    f32x16 oc[2] = {};
    {
      float* myimp = impH + (hh * 64 + ql) * 65;
      attn_loop(tid, list, ntile, kcb, 64, vcb, 256, Ks, Vs, [&](int key0, const u16* Ks, const u16* Vs) {
        f32x16 s[2];
        qk_scores(Ks, qf, lane, s);
        float ls = 0.f;
#pragma unroll
        for (int sb = 0; sb < 2; ++sb)
#pragma unroll
          for (int i = 0; i < 16; ++i) { const int n = key0 + keyoff(sb, i, hf); const bool v = (n < 255) && (16 * n + 31 <= pos); const float pv = v ? __builtin_amdgcn_exp2f(s[sb][i]) : 0.f; s[sb][i] = pv; ls += pv; }
        l += ls;
        pv_acc(Vs, s, oc, lane);
#pragma unroll
        for (int sb = 0; sb < 2; ++sb)
#pragma unroll
          for (int gi = 0; gi < 4; ++gi) {
            const int j = (key0 >> 2) + sb * 8 + gi * 2 + hf;
            myimp[j] += s[sb][gi * 4] + s[sb][gi * 4 + 1] + s[sb][gi * 4 + 2] + s[sb][gi * 4 + 3];
          }
#pragma unroll
        for (int sb = 0; sb < 2; ++sb)
#pragma unroll
          for (int gi = 0; gi < 4; ++gi) {
            const int j = (key0 >> 2) + sb * 8 + gi * 2 + hf + 1;
            if (j < 64) myimp[j] += s[sb][gi * 4 + 3];
          }
      });
    }
    l += __shfl_xor(l, 32);
    const float invc = (l > 0.f) ? 1.f / l : 0.f;
    if (hf == 0) invs[hh * 64 + ql] = invc;
    __syncthreads();
    {
      unsigned un0 = 0, un1 = 0;
      for (int qq = 0; qq < 8; ++qq) {
        const int q = wv * 8 + qq;
        const int j = lane;
        float v = ((impH[(0 * 64 + q) * 65 + j] * invs[q] + impH[(1 * 64 + q) * 65 + j] * invs[64 + q]) + (impH[(2 * 64 + q) * 65 + j] * invs[128 + q] + impH[(3 * 64 + q) * 65 + j] * invs[192 + q]));
        const bool valid = j <= c;
        const bool forced = (j == 0) || (j == c) || (j == c - 1);
        v = valid ? (forced ? 1e30f : v) : -1e30f;
        int rank = 0;
#pragma unroll
        for (int k = 0; k < 64; ++k) {
          const float vk = __builtin_bit_cast(float, __builtin_amdgcn_readlane(__builtin_bit_cast(int, v), k));
          rank += (vk > v || (vk == v && k < j)) ? 1 : 0;
        }
        const unsigned long long bm = __ballot((rank < 16) && valid);
        if (lane == 0) { selm[q * 2] = (unsigned)bm; selm[q * 2 + 1] = (unsigned)(bm >> 32); }
        un0 |= (unsigned)bm; un1 |= (unsigned)(bm >> 32);
      }
      if (tid == 0) { misc[0] = 0; misc[1] = 0; }
      __syncthreads();
      if (lane == 0) { atomicOr(&misc[0], un0); atomicOr(&misc[1], un1); }
      __syncthreads();
      if (tid == 0) {
        const unsigned long long un = (unsigned long long)misc[0] | ((unsigned long long)misc[1] << 32);
        int cn = 0;
        for (int j = 0; j <= c; ++j) if ((un >> j) & 1) list[cn++] = j * 64;
        misc[2] = cn;
      }
      __syncthreads();
    }
    {
      const float gcv = GATES[tok * 48 + h * 3 + 0] * invc;
#pragma unroll
      for (int db = 0; db < 2; ++db)
#pragma unroll
        for (int i = 0; i < 16; ++i) totl[(db * 16 + i) * 512 + tid] = oc[db][i] * gcv;
    }
    {
      const unsigned long long mym = (unsigned long long)selm[ql * 2] | ((unsigned long long)selm[ql * 2 + 1] << 32);
      unsigned long long wm = mym;
      { unsigned lo = (unsigned)wm, hi = (unsigned)(wm >> 32);
#pragma unroll
        for (int o = 1; o < 32; o <<= 1) { lo |= (unsigned)__shfl_xor((int)lo, o); hi |= (unsigned)__shfl_xor((int)hi, o); }
        wm = (unsigned long long)lo | ((unsigned long long)hi << 32); }
      const int cnt = (int)misc[2];
      f32x16 o[2] = {}; float ms = -1e30f, lsum = 0.f;
      attn_loop(tid, list, cnt, KSN + (size_t)b * S_ * 256 + g * 64, 256, VST + (size_t)(b * 256 + g * 64) * S_, S_, Ks, Vs, [&](int key0, const u16* Ks, const u16* Vs) {
        const int j = key0 >> 6;
        if ((wm >> j) & 1) {
          f32x16 s[2];
          qk_scores(Ks, qf, lane, s);
          if (j != c) prob_lane(s, lsum, (mym >> j) & 1);
          else prob_elem(s, lsum, lane, [&](int ko) { return key0 + ko <= pos; });
          pv_acc(Vs, s, o, lane);
        }
      });
      lsum += __shfl_xor(lsum, 32);
      { const float w = GATES[tok * 48 + h * 3 + 1] / lsum;
#pragma unroll
      for (int db = 0; db < 2; ++db)
#pragma unroll
        for (int i = 0; i < 16; ++i) totl[(db * 16 + i) * 512 + tid] += o[db][i] * w; }
    }
    {
      const int j0 = max(0, c - 8);
      if (tid < 16) list[tid] = (j0 + tid) * 64;
      __syncthreads();
      f32x16 o[2] = {}; float mw = -1e30f, lsum = 0.f;
      attn_loop(tid, list, c - j0 + 1, KWN + (size_t)b * S_ * 256 + g * 64, 256, VWT + (size_t)(b * 256 + g * 64) * S_, S_, Ks, Vs, [&](int key0, const u16* Ks, const u16* Vs) {
        f32x16 s[2];
        qk_scores(Ks, qf, lane, s);
        const int jt = key0 >> 6;
        if (jt > c - 8 && jt < c) prob_lane(s, lsum, true);
        else prob_elem(s, lsum, lane, [&](int ko) { const int kp = key0 + ko; return (kp <= pos) && (kp > pos - 512); });
        pv_acc(Vs, s, o, lane);
      });
      lsum += __shfl_xor(lsum, 32);
      { const float w = GATES[tok * 48 + h * 3 + 2] / lsum;
#pragma unroll
      for (int db = 0; db < 2; ++db)
#pragma unroll
        for (int i = 0; i < 16; ++i) o[db][i] = totl[(db * 16 + i) * 512 + tid] + o[db][i] * w; }
      store_out(O + tok * 1024 + h * 64, o, lane);
    }
    __syncthreads();
  }
}

DI void op_init(const Params& p, char* shm) {
  const float* x = p.in[0];
  u16* HB = (u16*)(p.ws + OFF_HB); float* SSQ = (float*)(p.ws + OFF_SSQ);
  const int tid = tidx(); const int wv = tid >> 6, lane = tid & 63;
  for (int row = bidx() * 8 + wv; row < T_; row += gdim() * 8) {
    float ss = 0.f;
#pragma unroll
    for (int i = 0; i < 4; ++i) {
      const int col = (i * 64 + lane) * 4;
      const float4 v = *(const float4*)(x + (size_t)row * D_ + col);
      ss += v.x * v.x + v.y * v.y + v.z * v.z + v.w * v.w;
      uint2 w; w.x = pack2(v.x, v.y); w.y = pack2(v.z, v.w);
      *(uint2*)(HB + (size_t)row * D_ + col) = w;
    }
#pragma unroll
    for (int o = 1; o < 64; o <<= 1) ss += __shfl_xor(ss, o);
    if (lane < 4) SSQ[(size_t)row * 4 + lane] = (lane == 0) ? ss : 0.f;
  }
  convert_layer(p, 0, shm, (int)blockIdx.x, (int)gridDim.x, 1);
}

template <int OPC, int KINDC>
DI void run_op(const Params& p, int L, int op_rt, char* shm) {
  const int op = (OPC >= 0) ? OPC : op_rt;
  const int kind = (KINDC >= 0) ? KINDC : L % 3, j = L / 3;
  char* ws = p.ws;
  asm volatile("" : "+s"(ws));
  char* scr = ws + OFF_SCR;
  u16* WT = (u16*)(ws + (size_t)(L & 1) * WT_BYTES);
  u16* HB = (u16*)(ws + OFF_HB); float* SSQ = (float*)(ws + OFF_SSQ);
  u16* HID = (u16*)scr;
  switch (op) {
    case OP_INIT: op_init(p, shm); break;
    case OP_UP1: case OP_UP2: {
      const int w = (op == OP_UP1) ? 0 : 2;
      GemmArgs g{HB, D_, WT + (w ? W_UP2 : W_UP1), D_, T_, 2 * F_, D_, -1, -1};
      gemm_phase(g, EpiSwiglu{HID, SSQ + (size_t)w * SSQ_STRIDE}, shm);
      if (op == OP_UP1) { if (L == 0) convert_on_idle(p, 0, shm, (T_ / 256) * (2 * F_ / 256), 2); }
      else convert_on_idle(p, L + 1, shm, (T_ / 256) * (2 * F_ / 256), 3);
    } break;
    case OP_DN1: case OP_DN2: {
      const bool first = (op == OP_DN1);
      GemmArgs g{HID, F_, WT + (first ? W_DN1 : W_DN2), F_, T_, D_, F_, -1, -1};
      float* nx = first ? SSQ + SSQ_STRIDE : (L < 3 ? SSQ : nullptr);
      if (PROBE_DUP & 64) { gemm_phase(g, EpiStore{(u16*)(scr + 100 * MB), D_, nullptr, 1 << 30}, shm); __syncthreads(); }
      gemm_phase(g, EpiResid{(!first && L == 3) ? p.out : nullptr, HB, nx, 0.5f}, shm);
    } break;
    case OP_IN: {
      const int N = (kind == 0) ? 3072 : (kind == 1) ? 2048 : 2816;
      GemmArgs g{HB, D_, WT + W_MIN, D_, T_, N, D_, -1, -1};
      if (kind == 0) gemm_phase(g, EpiMobaIn{(u16*)scr, SSQ + SSQ_STRIDE, p.in[8] + j * 64, (u16*)(scr + A_KN), (u16*)(scr + A_VT), (float*)(scr + A_KMEAN)}, shm);
      else gemm_phase(g, EpiStore{(u16*)scr, N, SSQ + SSQ_STRIDE, (kind == 1) ? 1024 : (1 << 30)}, shm);
    } break;
    case OP_OUT: {
      const u16* Oa = (const u16*)(scr + L_HY);
      GemmArgs g{Oa, D_, WT + W_MOUT, D_, T_, D_, D_, -1, -1};
      if (PROBE_DUP & 64) { gemm_phase(g, EpiStore{(u16*)(scr + 100 * MB), D_, nullptr, 1 << 30}, shm); __syncthreads(); }
      gemm_phase(g, EpiResid{nullptr, HB, SSQ + 2 * SSQ_STRIDE, 1.0f}, shm);
    } break;
    case OP_M1:
      if (kind == 0) moba_prep((const u16*)scr, p.in[8] + j * 64, (u16*)(scr + A_KN), (u16*)(scr + A_VT), (float*)(scr + A_KMEAN), shm);
      else if (kind == 1) lru_conv((const u16*)scr, p.in[11], p.in[12], (u16*)(scr + L_XC));
      else nsa_prep((const u16*)scr, p, scr, shm, 1, (int)blockIdx.x, (int)gridDim.x);
      break;
    case OP_M2:
      if (kind == 0) moba_attn((const u16*)scr, p.in[7] + j * 64, (const u16*)(scr + A_KN), (const u16*)(scr + A_VT), (const float*)(scr + A_KMEAN), (u16*)(scr + A_O), shm);
      else if (kind == 1) {
        GemmArgs g{(const u16*)(scr + L_XC), D_, WT + W_EXT, 256, T_, 2048, 256, 1, -1};
        gemm_phase(g, EpiLruGate{p.in[14], p.in[16], p.in[17], (const u16*)(scr + L_XC), (float*)(scr + L_A), (float*)(scr + L_B)}, shm);
      } else {
        GemmArgs g1{(const u16*)(scr + N_AK), 2048, WT + W_EXT, 2048, 8192, 256, 2048, -1, 4};
        gemm_phase(g1, EpiStore{(u16*)(scr + N_HK), 256, nullptr, 0}, shm);
        { const int nb = (int)gridDim.x, bid = (int)blockIdx.x;
          if (nb > 32) { if (bid >= 32) nsa_prep((const u16*)scr, p, scr, shm, 2, bid - 32, nb - 32); }
          else nsa_prep((const u16*)scr, p, scr, shm, 2, bid, nb); }
      }
      break;
    case OP_M3:
      if (kind == 1) lru_scan1((const float*)(scr + L_A), (const float*)(scr + L_B), (float*)(ws + OFF_PC), (float*)(ws + OFF_HC));
      else if (kind == 2) nsa_cmp2((const u16*)(scr + N_HK), (const u16*)(scr + N_HV), p.in[28], p.in[30], p.in[22], (u16*)(scr + N_KCMP), (u16*)(scr + N_VCMPT));
      break;
    case OP_M4:
      if (kind == 1) lru_scan2((const float*)(scr + L_A), (const float*)(scr + L_B), (const float*)(ws + OFF_PC), (const float*)(ws + OFF_HC), (const u16*)scr, (u16*)(scr + L_HY));
      else if (kind == 2) nsa_attn((const u16*)scr, p, scr, shm);
      break;
  }
}

#if MEGA
constexpr size_t OFF_BAR = 133 * MB;
constexpr int LDS_ST = 143360 - 32;
DI unsigned ld_agent(const unsigned* p) { return __hip_atomic_load(p, __ATOMIC_RELAXED, __HIP_MEMORY_SCOPE_AGENT); }
DI unsigned add_agent(unsigned* p) { return __hip_atomic_fetch_add(p, 1u, __ATOMIC_RELAXED, __HIP_MEMORY_SCOPE_AGENT); }
DI unsigned xcc_id() { return (unsigned)__builtin_amdgcn_s_getreg((3 << 11) | 20) & 0xFu; }
DI void bar_post(unsigned* bar) { if (tidx() == 0) (void)add_agent(&bar[1024 + 32 * xcc_id()]); }
DI void bar_setup(unsigned* bar, char* shm) {
  if (tidx() == 0) {
    const unsigned x = xcc_id(); unsigned nloc = 1, nx = 0;
    for (unsigned j = 0; j < 16; ++j) { const unsigned c = ld_agent(&bar[1024 + 32 * j]); nx += (c > 0u) ? 1u : 0u; if (j == x) nloc = c; }
    volatile unsigned* st = (volatile unsigned*)(shm + LDS_ST);
    st[0] = nloc; st[1] = nx; st[2] = x;
  }
  __syncthreads();
}
DI void grid_bar(unsigned* bar, char* shm) {
  asm volatile("s_waitcnt vmcnt(0)" ::: "memory");
  __syncthreads();
  if (tidx() == 0) {
    volatile unsigned* st = (volatile unsigned*)(shm + LDS_ST);
    const unsigned nloc = st[0], nx = st[1], x = st[2];
    const unsigned old = add_agent(&bar[32 * x]);
    const unsigned gen = old / nloc;
    if (old + 1u == (gen + 1u) * nloc) {
      __builtin_amdgcn_fence(__ATOMIC_RELEASE, "agent");
      asm volatile("s_waitcnt vmcnt(0)" ::: "memory");
      const unsigned og = add_agent(&bar[1536]);
      const unsigned tg = og / nx;
      if (og + 1u == (tg + 1u) * nx) (void)add_agent(&bar[1568]);
      else while (ld_agent(&bar[1568]) == tg) __builtin_amdgcn_s_sleep(1);
      __builtin_amdgcn_fence(__ATOMIC_ACQUIRE, "agent");
      (void)add_agent(&bar[512 + 32 * x]);
      asm volatile("s_waitcnt vmcnt(0)" ::: "memory");
    } else {
      while (ld_agent(&bar[512 + 32 * x]) == gen) __builtin_amdgcn_s_sleep(1);
      __builtin_amdgcn_fence(__ATOMIC_ACQUIRE, "agent");
      asm volatile("s_waitcnt vmcnt(0)" ::: "memory");
    }
  }
  __syncthreads();
}
typedef const __attribute__((address_space(4))) Params* KParams;
template <int OPC, int KINDC, bool SYNC>
DI void run_k(int L, char* shm) {
#if defined(__HIP_DEVICE_COMPILE__)
  KParams kp = (KParams)__builtin_amdgcn_kernarg_segment_ptr();
  asm volatile("" : "+s"(kp));
  const Params p = *kp;
  run_op<OPC, KINDC>(p, L, OPC, shm);
  {
    constexpr bool isA = (OPC == OP_UP1 || OPC == OP_UP2);
    constexpr bool isB = (OPC == OP_M2 && KINDC == 0) || (OPC == OP_M4 && KINDC == 2);
    constexpr bool isC = (OPC == OP_IN);
    constexpr bool isD = (OPC == OP_M1) || (OPC == OP_M3) || (OPC == OP_M2 && KINDC != 0) || (OPC == OP_M4 && KINDC == 1);
    if constexpr (((PROBE_DUP & 1) && isA) || ((PROBE_DUP & 2) && isB) || ((PROBE_DUP & 4) && isC) || ((PROBE_DUP & 8) && isD)) {
      __syncthreads();
      run_op<OPC, KINDC>(p, L, OPC, shm);
    }
  }
  if (SYNC) grid_bar((unsigned*)(p.ws + OFF_BAR), shm);
#endif
}
template <int L>
DI void run_layer(char* shm) {
  constexpr int kind = L % 3;
  run_k<OP_UP1, kind, true>(L, shm);
  run_k<OP_DN1, kind, true>(L, shm);
  run_k<OP_IN, kind, true>(L, shm);
  if constexpr (kind != 0) run_k<OP_M1, kind, true>(L, shm);
  run_k<OP_M2, kind, true>(L, shm);
  if constexpr (kind != 0) {
    run_k<OP_M3, kind, true>(L, shm);
    run_k<OP_M4, kind, true>(L, shm);
  }
  run_k<OP_OUT, kind, true>(L, shm);
  run_k<OP_UP2, kind, true>(L, shm);
  run_k<OP_DN2, kind, (L < 3)>(L, shm);
}
__global__ void __launch_bounds__(512) mega(Params pdummy, int lo, int hi, int coop) {
  extern __shared__ __attribute__((aligned(16))) char shm[];
  {
    KParams kp = (KParams)__builtin_amdgcn_kernarg_segment_ptr();
    bar_post((unsigned*)(kp->ws + OFF_BAR));
  }
  run_k<OP_INIT, -1, false>(0, shm);
  cg::this_grid().sync();
  {
    KParams kp = (KParams)__builtin_amdgcn_kernarg_segment_ptr();
    bar_setup((unsigned*)(kp->ws + OFF_BAR), shm);
  }
  run_layer<0>(shm);
  run_layer<1>(shm);
  run_layer<2>(shm);
  run_layer<3>(shm);
}
#endif
template <int OPC, int KINDC>
__global__ void __launch_bounds__(512) op_kernel(Params p, int L) {
  extern __shared__ __attribute__((aligned(16))) char shm[];
  run_op<OPC, KINDC>(p, L, OPC, shm);
}
template <int OPC, int KINDC>
static void launch_k(const Params& p, int L, int grid, size_t lds, hipStream_t stream) {
  static bool init = false;
  if (!init) { (void)hipFuncSetAttribute((const void*)op_kernel<OPC, KINDC>, hipFuncAttributeMaxDynamicSharedMemorySize, (int)lds); init = true; }
  op_kernel<OPC, KINDC><<<grid, 512, lds, stream>>>(p, L);
}
template <int OPC>
static void launch_op(const Params& p, int L, int grid, size_t lds, hipStream_t stream) {
  if constexpr (OPC == OP_IN || (OPC >= OP_M1 && OPC <= OP_M4)) {
    const int kind = L % 3;
    if (kind == 0) launch_k<OPC, 0>(p, L, grid, lds, stream);
    else if (kind == 1) launch_k<OPC, 1>(p, L, grid, lds, stream);
    else launch_k<OPC, 2>(p, L, grid, lds, stream);
  } else launch_k<OPC, -1>(p, L, grid, lds, stream);
}

extern "C" void kernel_launch(void* const* d_in, const int* in_sizes, int n_in, void* d_out, int out_size, void* d_ws, size_t ws_size,
                              hipStream_t stream) {
  constexpr size_t kDynLds = 140 * 1024;
  static int grid_blocks = 0;
  if (!grid_blocks) {
    int dev = 0, cus = 0;
    (void)hipGetDevice(&dev);
    (void)hipDeviceGetAttribute(&cus, hipDeviceAttributeMultiprocessorCount, dev);
#if MEGA
    (void)hipFuncSetAttribute((const void*)mega, hipFuncAttributeMaxDynamicSharedMemorySize, (int)kDynLds);
#endif
    grid_blocks = cus * 1;
  }
  Params p{};
  for (int i = 0; i < 32; ++i) p.in[i] = (const float*)d_in[i];
  p.out = (float*)d_out; p.ws = (char*)d_ws;
  int n = 0;
  p.prog[n++] = (0 << 4) | OP_INIT;
  for (int L = 0; L < 4; ++L) {
    const int kind = L % 3;
    p.prog[n++] = (L << 4) | OP_UP1; p.prog[n++] = (L << 4) | OP_DN1; p.prog[n++] = (L << 4) | OP_IN;
    p.prog[n++] = (L << 4) | OP_M1; p.prog[n++] = (L << 4) | OP_M2;
    if (kind != 0) { p.prog[n++] = (L << 4) | OP_M3; p.prog[n++] = (L << 4) | OP_M4; }
    p.prog[n++] = (L << 4) | OP_OUT; p.prog[n++] = (L << 4) | OP_UP2; p.prog[n++] = (L << 4) | OP_DN2;
  }
  p.nprog = n;
#if MEGA
  int lo = 0, hi = n, coop = 1;
  (void)hipMemsetAsync((char*)d_ws + OFF_BAR, 0, 8192, stream);
  void* args[] = {&p, &lo, &hi, &coop};
  hipError_t e = hipLaunchCooperativeKernel((void*)mega, dim3(grid_blocks), dim3(512), args, kDynLds, stream);
  if (e != hipSuccess) fprintf(stderr, "cooperative launch failed: %s (grid %d)\n", hipGetErrorString(e), grid_blocks);
#else
  for (int i = 0; i < n; ++i) {
    const int L = p.prog[i] >> 4, op = p.prog[i] & 15;
    switch (op) {
      case OP_INIT: launch_op<OP_INIT>(p, L, grid_blocks, kDynLds, stream); break;
      case OP_UP1: launch_op<OP_UP1>(p, L, grid_blocks, kDynLds, stream); break;
      case OP_DN1: launch_op<OP_DN1>(p, L, grid_blocks, kDynLds, stream); break;
      case OP_IN: launch_op<OP_IN>(p, L, grid_blocks, kDynLds, stream); break;
      case OP_M1: launch_op<OP_M1>(p, L, grid_blocks, kDynLds, stream); break;
      case OP_M2: launch_op<OP_M2>(p, L, grid_blocks, kDynLds, stream); break;
      case OP_M3: launch_op<OP_M3>(p, L, grid_blocks, kDynLds, stream); break;
      case OP_M4: launch_op<OP_M4>(p, L, grid_blocks, kDynLds, stream); break;
      case OP_OUT: launch_op<OP_OUT>(p, L, grid_blocks, kDynLds, stream); break;
      case OP_UP2: launch_op<OP_UP2>(p, L, grid_blocks, kDynLds, stream); break;
      case OP_DN2: launch_op<OP_DN2>(p, L, grid_blocks, kDynLds, stream); break;
    }
  }
#endif
}
```

```cpp
#include <hip/hip_runtime.h>
#include <hip/hip_cooperative_groups.h>
#include <stdint.h>
#include <cstdio>
namespace cg = cooperative_groups;

typedef unsigned short u16;
typedef short bf16x8 __attribute__((ext_vector_type(8)));
typedef short s16x4 __attribute__((ext_vector_type(4)));
typedef float f32x4 __attribute__((ext_vector_type(4)));
typedef float f32x16 __attribute__((ext_vector_type(16)));
#define DI __device__ __forceinline__

constexpr int T_ = 16384, S_ = 4096, D_ = 1024, F_ = 2816;
constexpr float EPS_ = 1e-6f;
constexpr float LOG2E = 1.4426950408889634f;

#ifndef PROBE_DUP
#define PROBE_DUP 0
#endif
#ifndef MEGA
#define MEGA 1
#endif

constexpr size_t MB = 1024 * 1024;
constexpr size_t WT_BYTES = 48 * MB;
constexpr size_t OFF_HB = 96 * MB;
constexpr size_t OFF_SSQ = 128 * MB;
constexpr size_t OFF_PC = 44 * MB;
constexpr size_t OFF_HC = 46 * MB;
constexpr size_t OFF_SCR = 134 * MB;
constexpr size_t SSQ_STRIDE = (size_t)T_ * 4;
constexpr size_t W_UP1 = 0, W_DN1 = W_UP1 + 5632 * 1024, W_UP2 = W_DN1 + 1024 * 2816, W_DN2 = W_UP2 + 5632 * 1024,
                 W_MIN = W_DN2 + 1024 * 2816, W_MOUT = W_MIN + 3072 * 1024, W_EXT = W_MOUT + 1024 * 1024;
constexpr size_t A_RAW = 0, A_KN = 104 * MB, A_VT = 136 * MB, A_O = 224 * MB, A_KMEAN = 200 * MB;
constexpr size_t L_RAW = 0, L_XC = 64 * MB, L_A = 96 * MB, L_B = 160 * MB, L_HY = 224 * MB;
constexpr size_t N_RAW = 0, N_KSN = 96 * MB, N_KWN = 104 * MB, N_VST = 112 * MB, N_VWT = 120 * MB, N_AK = 128 * MB,
                 N_AV = 144 * MB, N_HK = 162 * MB, N_HV = 164 * MB, N_KCMP = 166 * MB, N_VCMPT = 167 * MB, N_GATES = 168 * MB,
                 N_O = 224 * MB;

enum { OP_INIT = 0, OP_UP1, OP_DN1, OP_IN, OP_M1, OP_M2, OP_M3, OP_M4, OP_OUT, OP_UP2, OP_DN2 };

struct Params {
  const float* in[32];
  float* out;
  char* ws;
  int nprog;
  int pad0;
  unsigned char prog[64];
};

typedef __bf16 bf16x2_t __attribute__((ext_vector_type(2)));
typedef float f32x2_t __attribute__((ext_vector_type(2)));
DI unsigned pack2(float a, float b) { f32x2_t f = {a, b}; bf16x2_t h = __builtin_convertvector(f, bf16x2_t); return __builtin_bit_cast(unsigned, h); }
DI u16 f2bf(float x) { return (u16)(pack2(x, 0.f) & 0xffffu); }
DI float bf2f(u16 v) { return __uint_as_float(((unsigned)v) << 16); }
DI float gelu_t(float x) { float u = 1.5957691216057308f * (x + 0.044715f * x * x * x); return x * __builtin_amdgcn_rcpf(1.f + __expf(-u)); }
DI float sigmoidf(float x) { return __builtin_amdgcn_rcpf(1.f + __expf(-x)); }
DI int bidx() { int t = blockIdx.x; asm volatile("" : "+s"(t)); return t; }
DI int gdim() { int t = gridDim.x; asm volatile("" : "+s"(t)); return t; }
DI int tidx() { int t = threadIdx.x; asm volatile("" : "+v"(t)); return t; }

DI void conv_job(const float* src, const float* src2, int ld, int K, int R, int nvalid, int kind, const float* g, u16* dst, char* shm, int vbid, int vnb) {
  float* tile = (float*)shm;
  const int ntk = K / 64, ntr = R / 64, tid = tidx();
  for (int t = vbid; t < ntr * ntk; t += vnb) {
    const int tr = t / ntk, tk = t % ntk, r0 = tr * 64, k0 = tk * 64;
    const float* sp = src; int col0 = r0, nv = nvalid - r0, sld = ld;
    if (kind == 1) { int tile256 = r0 >> 8, within = r0 & 255, half = within >> 7, c = within & 127; col0 = half * 2816 + tile256 * 128 + c; nv = 64; }
    else if (kind == 2) { int pn = r0 >> 8, within = r0 & 255, half = within >> 7, c = within & 127; sp = (half ? src2 : src) + (size_t)(pn >> 1) * 65536; col0 = (pn & 1) * 128 + c; nv = 64; sld = 256; }
    {
      const int kk = tid >> 4, c4 = (tid & 15) * 4;
#pragma unroll
      for (int ps = 0; ps < 2; ++ps) {
        const int k = kk + ps * 32;
        float4 v = make_float4(0.f, 0.f, 0.f, 0.f);
        if (c4 < nv) v = *(const float4*)(sp + (size_t)(k0 + k) * sld + col0 + c4);
        const float gg = g ? g[k0 + k] : 1.f;
        tile[k * 65 + c4 + 0] = v.x * gg; tile[k * 65 + c4 + 1] = v.y * gg; tile[k * 65 + c4 + 2] = v.z * gg; tile[k * 65 + c4 + 3] = v.w * gg;
      }
    }
    __syncthreads();
    {
      const int n = tid >> 3, ks = (tid & 7) * 8;
      uint4 w;
      w.x = pack2(tile[(ks + 0) * 65 + n], tile[(ks + 1) * 65 + n]);
      w.y = pack2(tile[(ks + 2) * 65 + n], tile[(ks + 3) * 65 + n]);
      w.z = pack2(tile[(ks + 4) * 65 + n], tile[(ks + 5) * 65 + n]);
      w.w = pack2(tile[(ks + 6) * 65 + n], tile[(ks + 7) * 65 + n]);
      *(uint4*)(dst + (size_t)(r0 + n) * K + k0 + ks) = w;
    }
    __syncthreads();
  }
}

DI void convert_layer(const Params& p, int L, char* shm, int vbid, int vnb, int mask) {
  if (L >= 4) return;
  const int kind = L % 3, j = L / 3;
  u16* WT = (u16*)(p.ws + (size_t)(L & 1) * WT_BYTES);
  const float* ng = p.in[1] + (size_t)L * 3 * 1024;
  if (mask & 1) conv_job(p.in[2] + (size_t)L * 1024 * 5632, nullptr, 5632, 1024, 5632, 5632, 1, ng, WT + W_UP1, shm, vbid, vnb);
  if (!(mask & 2)) return;
  conv_job(p.in[3] + (size_t)L * 2816 * 1024, nullptr, 1024, 2816, 1024, 1024, 0, nullptr, WT + W_DN1, shm, vbid, vnb);
  conv_job(p.in[4] + (size_t)L * 1024 * 5632, nullptr, 5632, 1024, 5632, 5632, 1, ng + 2048, WT + W_UP2, shm, vbid, vnb);
  conv_job(p.in[5] + (size_t)L * 2816 * 1024, nullptr, 1024, 2816, 1024, 1024, 0, nullptr, WT + W_DN2, shm, vbid, vnb);
  if (kind == 0) {
    conv_job(p.in[6] + (size_t)j * 1024 * 3072, nullptr, 3072, 1024, 3072, 3072, 0, ng + 1024, WT + W_MIN, shm, vbid, vnb);
    conv_job(p.in[9] + (size_t)j * 1024 * 1024, nullptr, 1024, 1024, 1024, 1024, 0, nullptr, WT + W_MOUT, shm, vbid, vnb);
  } else if (kind == 1) {
    conv_job(p.in[10], nullptr, 2048, 1024, 2048, 2048, 0, ng + 1024, WT + W_MIN, shm, vbid, vnb);
    conv_job(p.in[18], nullptr, 1024, 1024, 1024, 1024, 0, nullptr, WT + W_MOUT, shm, vbid, vnb);
    conv_job(p.in[13], p.in[15], 256, 256, 2048, 2048, 2, nullptr, WT + W_EXT, shm, vbid, vnb);
  } else {
    conv_job(p.in[19], nullptr, 2608, 1024, 2816, 2608, 0, ng + 1024, WT + W_MIN, shm, vbid, vnb);
    conv_job(p.in[31], nullptr, 1024, 1024, 1024, 1024, 0, nullptr, WT + W_MOUT, shm, vbid, vnb);
    conv_job(p.in[27], nullptr, 256, 2048, 256, 256, 0, nullptr, WT + W_EXT, shm, vbid, vnb);
    conv_job(p.in[29], nullptr, 256, 2048, 256, 256, 0, nullptr, WT + W_EXT + 256 * 2048, shm, vbid, vnb);
  }
}
DI void convert_on_idle(const Params& p, int L, char* shm, int ntiles, int mask) {
  const int nb = (int)gridDim.x, bid = (int)blockIdx.x;
  const int rem = __builtin_amdgcn_readfirstlane(ntiles % nb);
  if (rem == 0) convert_layer(p, L, shm, bid, nb, mask);
  else if (bid >= rem) convert_layer(p, L, shm, bid - rem, nb - rem, mask);
}

constexpr int STG_LD = 260;
constexpr int BM = 256, BK = 64, HALF = 128, NXCD = 8, WGM = 8, HT = HALF * BK, SHM_B = 8 * HT * 2;

DI int lds_byte(int r, int c) {
  int st = (r >> 4) * 2 + (c >> 5), rr = r & 15, cc = c & 31, ob = rr * 64 + cc * 2;
  return st * 1024 + (ob ^ (((ob >> 9) & 1) << 5));
}
DI void stage_rc(int b, int& R, int& C) {
  int st = b / 1024, sb = b % 1024, swz = sb ^ (((sb >> 9) & 1) << 5);
  R = (st >> 1) * 16 + swz / 64; C = (st & 1) * 32 + (swz % 64) / 2;
}

DI void glds16(const void* sbase, unsigned voff, unsigned lds_addr) {
  unsigned keep;
  asm volatile("s_mov_b32 %0, m0\n\ts_mov_b32 m0, %3\n\ts_nop 0\n\tglobal_load_lds_dwordx4 %1, %2\n\ts_mov_b32 m0, %0"
               : "=&s"(keep) : "v"(voff), "s"(sbase), "s"(lds_addr) : "memory");
}
struct GemmArgs { const u16* A; int lda; const u16* Bt; int ldb; int M, N, K; int a_pn_shift; int b_pm_shift; };

template <class Epi>
DI void gemm_phase(const GemmArgs& g, const Epi& epi, char* shmc) {
  u16* shm = (u16*)shmc;
  const int tid_ = tidx();
  const int lda = g.lda, ldb = g.ldb, K = g.K;
#define SA(b, h) (shm + ((b)*4 + (h)) * HT)
#define SB(b, h) (shm + ((b)*4 + 2 + (h)) * HT)
#define STAGE(P, BASE, LD, br, kt)                                                                                  \
  do {                                                                                                              \
    const u16* _ub = (BASE) + ((long)(br) * (LD) + (long)(kt)*BK);                                                  \
    const unsigned _la = lds0 + (unsigned)((char*)(P) - shmc);     \
    glds16(_ub, so_##LD[0], _la);                                                                                   \
    glds16(_ub, so_##LD[1], _la + 8192u);                                                                           \
  } while (0)
#define LDA(dst, b, h)                                                                                              \
  for (int m = 0; m < 4; ++m) for (int k = 0; k < 2; ++k)                                                           \
    dst[m][k] = *reinterpret_cast<const bf16x8*>((char*)SA(b, h) + lds_byte(wr * 64 + m * 16 + fr, k * 32 + fq * 8))
#define LDB(dst, b, h)                                                                                              \
  for (int n = 0; n < 2; ++n) for (int k = 0; k < 2; ++k)                                                           \
    dst[n][k] = *reinterpret_cast<const bf16x8*>((char*)SB(b, h) + lds_byte(wc * 32 + n * 16 + fr, k * 32 + fq * 8))
#define MMA(ai, bj, At_, Bt_)                                                                                       \
  do {                                                                                                              \
    __builtin_amdgcn_s_setprio(1);                                                                                  \
    for (int m = 0; m < 4; ++m) for (int n = 0; n < 2; ++n) for (int k = 0; k < 2; ++k)                             \
      acc[ai][bj][m][n] = __builtin_amdgcn_mfma_f32_16x16x32_bf16(Bt_[n][k], At_[m][k], acc[ai][bj][m][n], 0, 0, 0); \
    __builtin_amdgcn_s_setprio(0);                                                                                  \
  } while (0)
#define WAIT_V(n) asm volatile("s_waitcnt vmcnt(" #n ")" ::: "memory")
#define WAIT_L(n) asm volatile("s_waitcnt lgkmcnt(" #n ")" ::: "memory")
#define BAR __builtin_amdgcn_s_barrier()
#define SCHED __builtin_amdgcn_sched_barrier(0)

  const int nM = g.M / BM, nN = g.N / BM, nwg = nM * nN;
  const int wid = tid_ >> 6, lane = tid_ & 63, wr = wid >> 2, wc = wid & 3, fr = lane & 15, fq = lane >> 4;
  int nt = K / BK;
  asm volatile("" : "+s"(nt));
  const unsigned lds0 = (unsigned)__builtin_amdgcn_readfirstlane((int)((unsigned)(size_t)(__attribute__((address_space(3))) char*)shmc + (unsigned)(tid_ & ~63) * 16u));
  unsigned so_lda[2], so_ldb[2];
  for (int _i = 0; _i < 2; ++_i) { int _r, _c; stage_rc(tid_ * 16 + _i * 8192, _r, _c); so_lda[_i] = (unsigned)(_r * lda + _c) * 2u; so_ldb[_i] = (unsigned)(_r * ldb + _c) * 2u; }
#define TILE_COORDS(tile_, pm_, pn_)                                                                               \
  do {                                                                                                              \
    int wgid = (tile_);                                                                                             \
    { int q = nwg / NXCD, r = nwg % NXCD, xcd = wgid % NXCD, off = wgid / NXCD; wgid = (xcd < r ? xcd * (q + 1) : r * (q + 1) + (xcd - r) * q) + off; } \
    int nig = WGM * nN, gid = wgid / nig, fm = gid * WGM, gsz = min(nM - fm, WGM);                                  \
    pm_ = fm + ((wgid % nig) % gsz); pn_ = (wgid % nig) / gsz;                                                      \
  } while (0)
#define FIRST_STAGES(pm_, pn_)                                                                                      \
  do {                                                                                                              \
    const u16* A_ = g.A + (g.a_pn_shift >= 0 ? (size_t)((pn_) >> g.a_pn_shift) * K : 0);                            \
    const u16* Bt_ = g.Bt + (g.b_pm_shift >= 0 ? (size_t)((pm_) >> g.b_pm_shift) * ((size_t)g.N * K) : 0);          \
    STAGE(SB(0, 0), Bt_, ldb, (pn_)*BM, 0); STAGE(SA(0, 0), A_, lda, (pm_)*BM, 0);                                  \
    STAGE(SB(0, 1), Bt_, ldb, (pn_)*BM + HALF, 0); STAGE(SA(0, 1), A_, lda, (pm_)*BM + HALF, 0);                    \
  } while (0)
  const int gstep = gdim();
  int tile = bidx(), pm = 0, pn = 0;
  if (tile < nwg) { TILE_COORDS(tile, pm, pn); FIRST_STAGES(pm, pn); }
  while (tile < nwg) {
    const int brow = pm * BM, bcol = pn * BM;
    const u16* __restrict__ A = g.A + (g.a_pn_shift >= 0 ? (size_t)(pn >> g.a_pn_shift) * K : 0);
    const u16* __restrict__ Bt = g.Bt + (g.b_pm_shift >= 0 ? (size_t)(pm >> g.b_pm_shift) * ((size_t)g.N * K) : 0);
    f32x4 acc[2][2][4][2] = {};
    bf16x8 At[4][2], B0[2][2], B1[2][2];
    if (wr == 1) BAR;
    WAIT_V(4); BAR;
    STAGE(SB(1, 0), Bt, ldb, bcol, 1); STAGE(SA(1, 0), A, lda, brow, 1); STAGE(SB(1, 1), Bt, ldb, bcol + HALF, 1);
    WAIT_V(6); BAR;
    for (int t = 0; t < nt - 2; t += 2) {
      LDB(B0, 0, 0); SCHED; LDA(At, 0, 0); STAGE(SA(1, 1), A, lda, brow + HALF, t + 1);
      WAIT_L(8); BAR; WAIT_L(0); MMA(0, 0, At, B0); BAR; SCHED;
      LDB(B1, 0, 1); STAGE(SB(0, 0), Bt, ldb, bcol, t + 2);
      BAR; WAIT_L(0); MMA(0, 1, At, B1); BAR;
      LDA(At, 0, 1); STAGE(SA(0, 0), A, lda, brow, t + 2);
      BAR; WAIT_L(0); MMA(1, 0, At, B0); BAR; SCHED;
      STAGE(SB(0, 1), Bt, ldb, bcol + HALF, t + 2);
      WAIT_V(6); BAR; MMA(1, 1, At, B1); BAR;
      LDB(B0, 1, 0); SCHED; LDA(At, 1, 0); STAGE(SA(0, 1), A, lda, brow + HALF, t + 2);
      WAIT_L(8); BAR; WAIT_L(0); MMA(0, 0, At, B0); BAR; SCHED;
      LDB(B1, 1, 1); STAGE(SB(1, 0), Bt, ldb, bcol, t + 3);
      BAR; WAIT_L(0); MMA(0, 1, At, B1); BAR;
      LDA(At, 1, 1); STAGE(SA(1, 0), A, lda, brow, t + 3);
      BAR; WAIT_L(0); MMA(1, 0, At, B0); BAR; SCHED;
      STAGE(SB(1, 1), Bt, ldb, bcol + HALF, t + 3);
      WAIT_V(6); BAR; MMA(1, 1, At, B1); BAR;
    }
    { LDB(B0, 0, 0); LDA(At, 0, 0); STAGE(SA(1, 1), A, lda, brow + HALF, nt - 1);
      BAR; WAIT_L(0); MMA(0, 0, At, B0); BAR;
      LDB(B1, 0, 1); BAR; WAIT_L(0); MMA(0, 1, At, B1); BAR;
      LDA(At, 0, 1); WAIT_V(4); BAR; WAIT_L(0); MMA(1, 0, At, B0); MMA(1, 1, At, B1); BAR; }
    { LDB(B0, 1, 0); LDA(At, 1, 0); WAIT_V(2); BAR; WAIT_L(0); MMA(0, 0, At, B0); BAR;
      LDB(B1, 1, 1); WAIT_V(0); BAR; WAIT_L(0); MMA(0, 1, At, B1); BAR;
      LDA(At, 1, 1); BAR; WAIT_L(0); MMA(1, 0, At, B0); MMA(1, 1, At, B1); BAR; }
    if (wr == 0) BAR;
    const int ntile = tile + gstep; int npm = 0, npn = 0;
    if (ntile < nwg) { TILE_COORDS(ntile, npm, npn); FIRST_STAGES(npm, npn); }
    {
      int t2 = threadIdx.x;
      asm volatile("" : "+v"(t2));
      const int wid2 = t2 >> 6, lane2 = t2 & 63, wr2 = wid2 >> 2, wc2 = wid2 & 3, fr2 = lane2 & 15, fq2 = lane2 >> 4;
      if constexpr (Epi::REGMODE) {
        epi.reg(acc, shmc + 65536, brow, pn, t2);
      } else {
      float* stg = (float*)(shmc + 65536);
      typename Epi::Pre pre[2];
      epi.pre(pre[0], brow, pn, wid2, lane2);
#pragma unroll
      for (int q = 0; q < 4; ++q) {
        if (q > 0) __syncthreads();
        if (wr2 == (q & 1)) {
#pragma unroll
          for (int m = 0; m < 4; ++m)
#pragma unroll
            for (int bj = 0; bj < 2; ++bj)
#pragma unroll
              for (int n = 0; n < 2; ++n)
                *(f32x4*)(stg + (m * 16 + fr2) * STG_LD + bj * 128 + wc2 * 32 + n * 16 + fq2 * 4) = acc[q >> 1][bj][m][n];
        }
        __syncthreads();
        if (q < 3) epi.pre(pre[(q + 1) & 1], brow + (q + 1) * 64, pn, wid2, lane2);
        epi(pre[q & 1], stg, brow + q * 64, pn, wid2, lane2);
      }
      }
    }
    __syncthreads();
    tile = ntile; pm = npm; pn = npn;
  }
#undef TILE_COORDS
#undef FIRST_STAGES
#undef SA
#undef SB
#undef STAGE
#undef LDA
#undef LDB
#undef MMA
}

typedef f32x4 AccT[2][2][4][2];
DI float row_rstd(const float* ssq, int row) {
  const f32x4 a = *(const f32x4*)(ssq + (size_t)row * 4);
  return rsqrtf(((a[0] + a[1]) + (a[2] + a[3])) * (1.f / 1024.f) + EPS_);
}
struct EpiStore {
  u16* O; int ldc; const float* ssq; int gelu_from;
  static constexpr bool REGMODE = true;
  DI void reg(const AccT& acc, char* lds, int brow, int pn, int t2) const {
    const int wid = t2 >> 6, lane = t2 & 63, wr = wid >> 2, wc = wid & 3, fr = lane & 15, fq = lane >> 4;
    u16* st = (u16*)lds;
    const bool dog = (pn * 256 >= gelu_from);
#pragma unroll
    for (int ai = 0; ai < 2; ++ai) {
      if (ai == 1) __syncthreads();
      f32x4 pq[4];
      if (ssq) {
#pragma unroll
        for (int m = 0; m < 4; ++m) pq[m] = *(const f32x4*)(ssq + (size_t)(brow + ai * 128 + wr * 64 + m * 16 + fr) * 4);
      }
#pragma unroll
      for (int m = 0; m < 4; ++m) {
        const int rl = wr * 64 + m * 16 + fr;
        const float rs = ssq ? rsqrtf(((pq[m][0] + pq[m][1]) + (pq[m][2] + pq[m][3])) * (1.f / 1024.f) + EPS_) : 1.f;
#pragma unroll
        for (int bj = 0; bj < 2; ++bj)
#pragma unroll
          for (int n = 0; n < 2; ++n) {
            f32x4 v = acc[ai][bj][m][n] * rs;
            if (dog) { v[0] = gelu_t(v[0]); v[1] = gelu_t(v[1]); v[2] = gelu_t(v[2]); v[3] = gelu_t(v[3]); }
            uint2 w; w.x = pack2(v[0], v[1]); w.y = pack2(v[2], v[3]);
            *(uint2*)(st + rl * 264 + bj * 128 + wc * 32 + n * 16 + fq * 4) = w;
          }
      }
      __syncthreads();
#pragma unroll
      for (int i = 0; i < 8; ++i) {
        const int c = t2 + 512 * i, row = c >> 5, seg = c & 31;
        const uint4 w = *(const uint4*)(st + row * 264 + seg * 8);
        *(uint4*)(O + (size_t)(brow + ai * 128 + row) * ldc + pn * 256 + seg * 8) = w;
      }
    }
  }
  struct Pre {};
  DI void pre(Pre&, int, int, int, int) const {}
  DI void operator()(const Pre&, const float* stg, int brow, int pn, int wv, int lane) const {
    const bool dog = (pn * 256 >= gelu_from);
#pragma unroll 4
    for (int rr = wv; rr < 64; rr += 8) {
      const int row = brow + rr;
      const float rs = ssq ? row_rstd(ssq, row) : 1.f;
      f32x4 v = *(const f32x4*)(stg + rr * STG_LD + lane * 4) * rs;
      if (dog) { v[0] = gelu_t(v[0]); v[1] = gelu_t(v[1]); v[2] = gelu_t(v[2]); v[3] = gelu_t(v[3]); }
      uint2 w; w.x = pack2(v[0], v[1]); w.y = pack2(v[2], v[3]);
      *(uint2*)(O + (size_t)row * ldc + pn * 256 + lane * 4) = w;
    }
  }
};

struct EpiMobaIn {
  u16* RAW; const float* ssq; const float* kgain; u16* KN; u16* VT; float* KMEAN;
  static constexpr bool REGMODE = true;
  struct Pre {};
  DI void pre(Pre&, int, int, int, int) const {}
  DI void operator()(const Pre&, const float*, int, int, int, int) const {}
  DI void reg(const AccT& acc, char* lds, int brow, int pn, int t2) const {
    const int wid = t2 >> 6, lane = t2 & 63, wr = wid >> 2, wc = wid & 3, fr = lane & 15, fq = lane >> 4;
    u16* st = (u16*)lds;
    float* red = (float*)(lds + 67584);
    const int b = brow >> 12, tloc = brow & (S_ - 1), nblk = tloc >> 8;
    float ksum = 0.f;
#pragma unroll
    for (int ai = 0; ai < 2; ++ai) {
      if (ai == 1) __syncthreads();
      f32x4 pq[4];
#pragma unroll
      for (int m = 0; m < 4; ++m) pq[m] = *(const f32x4*)(ssq + (size_t)(brow + ai * 128 + wr * 64 + m * 16 + fr) * 4);
#pragma unroll
      for (int m = 0; m < 4; ++m) {
        const int rl = wr * 64 + m * 16 + fr;
        const float rs = rsqrtf(((pq[m][0] + pq[m][1]) + (pq[m][2] + pq[m][3])) * (1.f / 1024.f) + EPS_);
#pragma unroll
        for (int bj = 0; bj < 2; ++bj)
#pragma unroll
          for (int n = 0; n < 2; ++n) {
            const f32x4 v = acc[ai][bj][m][n] * rs;
            uint2 w; w.x = pack2(v[0], v[1]); w.y = pack2(v[2], v[3]);
            *(uint2*)(st + rl * 264 + bj * 128 + wc * 32 + n * 16 + fq * 4) = w;
          }
      }
      __syncthreads();
      if (pn < 4) {
#pragma unroll
        for (int i = 0; i < 8; ++i) {
          const int c = t2 + 512 * i, row = c >> 5, seg = c & 31;
          const uint4 w = *(const uint4*)(st + row * 264 + seg * 8);
          *(uint4*)(RAW + (size_t)(brow + ai * 128 + row) * 3072 + pn * 256 + seg * 8) = w;
        }
      } else if (pn < 8) {
        const int seg = t2 & 31, d0 = (seg & 7) * 8;
        float gn[8], cs[8];
#pragma unroll
        for (int j = 0; j < 8; ++j) { gn[j] = kgain[d0 + j]; cs[j] = 0.f; }
#pragma unroll
        for (int i = 0; i < 8; ++i) {
          const int row = (t2 >> 5) + 16 * i;
          const uint4 w = *(const uint4*)(st + row * 264 + seg * 8);
          const unsigned uu[4] = {w.x, w.y, w.z, w.w};
          float v[8]; float ss = 0.f;
#pragma unroll
          for (int q = 0; q < 4; ++q) { v[2 * q] = bf2f((u16)(uu[q] & 0xffff)); v[2 * q + 1] = bf2f((u16)(uu[q] >> 16)); }
#pragma unroll
          for (int j = 0; j < 8; ++j) ss += v[j] * v[j];
          ss += __shfl_xor(ss, 1); ss += __shfl_xor(ss, 2); ss += __shfl_xor(ss, 4);
          const float r2 = rsqrtf(ss * (1.f / 64.f) + EPS_);
#pragma unroll
          for (int j = 0; j < 8; ++j) { v[j] = v[j] * r2 * gn[j]; cs[j] += v[j]; }
          uint4 o4; o4.x = pack2(v[0], v[1]); o4.y = pack2(v[2], v[3]); o4.z = pack2(v[4], v[5]); o4.w = pack2(v[6], v[7]);
          *(uint4*)(KN + (size_t)(brow + ai * 128 + row) * 1024 + (pn - 4) * 256 + seg * 8) = o4;
        }
#pragma unroll
        for (int j = 0; j < 8; ++j) cs[j] += __shfl_xor(cs[j], 32);
        if (lane < 32) {
#pragma unroll
          for (int j = 0; j < 8; ++j) red[wid * 256 + seg * 8 + j] = cs[j];
        }
        __syncthreads();
        if (t2 < 256) { float sm = 0.f;
#pragma unroll
          for (int w8 = 0; w8 < 8; ++w8) sm += red[w8 * 256 + t2];
          ksum += sm; }
      } else {
#pragma unroll
        for (int i = 0; i < 8; ++i) {
          const int item = t2 + 512 * i, rg = item & 15, col = item >> 4;
          unsigned uu[4];
#pragma unroll
          for (int q = 0; q < 4; ++q) uu[q] = (unsigned)st[(rg * 8 + 2 * q) * 264 + col] | ((unsigned)st[(rg * 8 + 2 * q + 1) * 264 + col] << 16);
          uint4 o4; o4.x = uu[0]; o4.y = uu[1]; o4.z = uu[2]; o4.w = uu[3];
          *(uint4*)(VT + (size_t)(b * 1024 + (pn - 8) * 256 + col) * S_ + tloc + ai * 128 + rg * 8) = o4;
        }
      }
    }
    if (pn >= 4 && pn < 8 && t2 < 256) KMEAN[((size_t)(b * 16 + (pn - 4) * 4 + (t2 >> 6)) * 16 + nblk) * 64 + (t2 & 63)] = ksum * (1.f / 256.f);
  }
};

struct EpiSwiglu {
  u16* O; const float* ssq;
  static constexpr bool REGMODE = true;
  DI void reg(const AccT& acc, char* lds, int brow, int pn, int t2) const {
    const int wid = t2 >> 6, lane = t2 & 63, wr = wid >> 2, wc = wid & 3, fr = lane & 15, fq = lane >> 4;
    u16* st = (u16*)lds;
    f32x4 pq[8];
#pragma unroll
    for (int q = 0; q < 8; ++q) pq[q] = *(const f32x4*)(ssq + (size_t)(brow + (q >> 2) * 128 + wr * 64 + (q & 3) * 16 + fr) * 4);
#pragma unroll
    for (int ai = 0; ai < 2; ++ai)
#pragma unroll
      for (int m = 0; m < 4; ++m) {
        const int rl = ai * 128 + wr * 64 + m * 16 + fr;
        const f32x4 q4 = pq[ai * 4 + m];
        const float rs = rsqrtf(((q4[0] + q4[1]) + (q4[2] + q4[3])) * (1.f / 1024.f) + EPS_);
#pragma unroll
        for (int n = 0; n < 2; ++n) {
          const f32x4 gt = acc[ai][0][m][n] * rs, up = acc[ai][1][m][n] * rs;
          f32x4 v;
#pragma unroll
          for (int j = 0; j < 4; ++j) v[j] = gt[j] * sigmoidf(gt[j]) * up[j];
          uint2 w; w.x = pack2(v[0], v[1]); w.y = pack2(v[2], v[3]);
          *(uint2*)(st + rl * 136 + wc * 32 + n * 16 + fq * 4) = w;
        }
      }
    __syncthreads();
#pragma unroll
    for (int i = 0; i < 8; ++i) {
      const int c = t2 + 512 * i, row = c >> 4, seg = c & 15;
      const uint4 w = *(const uint4*)(st + row * 136 + seg * 8);
      *(uint4*)(O + (size_t)(brow + row) * F_ + pn * 128 + seg * 8) = w;
    }
  }
  struct Pre {};
  DI void pre(Pre&, int, int, int, int) const {}
  DI void operator()(const Pre&, const float* stg, int brow, int pn, int wv, int lane) const {
    const int l32 = lane & 31;
#pragma unroll 4
    for (int rp = wv; rp < 32; rp += 8) {
      const int rr = rp * 2 + (lane >> 5), row = brow + rr;
      const float rs = row_rstd(ssq, row);
      const f32x4 gt = *(const f32x4*)(stg + rr * STG_LD + l32 * 4) * rs, up = *(const f32x4*)(stg + rr * STG_LD + 128 + l32 * 4) * rs;
      f32x4 v;
#pragma unroll
      for (int j = 0; j < 4; ++j) v[j] = gt[j] * sigmoidf(gt[j]) * up[j];
      uint2 w; w.x = pack2(v[0], v[1]); w.y = pack2(v[2], v[3]);
      *(uint2*)(O + (size_t)row * F_ + pn * 128 + l32 * 4) = w;
    }
  }
};

struct EpiResid {
  float* fout; u16* hb; float* ssq_next; float scale;
  static constexpr bool REGMODE = true;
  struct Pre {};
  DI void pre(Pre&, int, int, int, int) const {}
  DI void operator()(const Pre&, const float*, int, int, int, int) const {}
  DI void reg(const AccT& acc, char* lds, int brow, int pn, int t2) const {
    const int wid = t2 >> 6, lane = t2 & 63, wr = wid >> 2, wc = wid & 3, fr = lane & 15, fq = lane >> 4;
    u16* st = (u16*)lds;
#pragma unroll
    for (int ai = 0; ai < 2; ++ai) {
      if (ai == 1) __syncthreads();
      uint4 hq[8];
#pragma unroll
      for (int i = 0; i < 8; ++i) { const int c = t2 + 512 * i; hq[i] = *(const uint4*)(hb + (size_t)(brow + ai * 128 + (c >> 5)) * D_ + pn * 256 + (c & 31) * 8); }
#pragma unroll
      for (int m = 0; m < 4; ++m) {
        const int rl = wr * 64 + m * 16 + fr;
#pragma unroll
        for (int bj = 0; bj < 2; ++bj)
#pragma unroll
          for (int n = 0; n < 2; ++n) {
            const f32x4 v = acc[ai][bj][m][n] * scale;
            uint2 w; w.x = pack2(v[0], v[1]); w.y = pack2(v[2], v[3]);
            *(uint2*)(st + rl * 264 + bj * 128 + wc * 32 + n * 16 + fq * 4) = w;
          }
      }
      __syncthreads();
#pragma unroll
      for (int i = 0; i < 8; ++i) {
        const int c = t2 + 512 * i, row = c >> 5, seg = c & 31;
        const uint4 dw = *(const uint4*)(st + row * 264 + seg * 8);
        const unsigned du[4] = {dw.x, dw.y, dw.z, dw.w}, hu[4] = {hq[i].x, hq[i].y, hq[i].z, hq[i].w};
        float hv[8]; float sq = 0.f;
#pragma unroll
        for (int q = 0; q < 4; ++q) {
          hv[2 * q] = bf2f((u16)(hu[q] & 0xffff)) + bf2f((u16)(du[q] & 0xffff));
          hv[2 * q + 1] = bf2f((u16)(hu[q] >> 16)) + bf2f((u16)(du[q] >> 16));
          sq += hv[2 * q] * hv[2 * q] + hv[2 * q + 1] * hv[2 * q + 1];
        }
        const size_t idx = (size_t)(brow + ai * 128 + row) * D_ + pn * 256 + seg * 8;
        if (fout) { *(f32x4*)(fout + idx) = (f32x4){hv[0], hv[1], hv[2], hv[3]}; *(f32x4*)(fout + idx + 4) = (f32x4){hv[4], hv[5], hv[6], hv[7]}; }
        uint4 o4; o4.x = pack2(hv[0], hv[1]); o4.y = pack2(hv[2], hv[3]); o4.z = pack2(hv[4], hv[5]); o4.w = pack2(hv[6], hv[7]);
        if (!fout) *(uint4*)(hb + idx) = o4;
        if (ssq_next) {
          sq += __shfl_xor(sq, 1); sq += __shfl_xor(sq, 2); sq += __shfl_xor(sq, 4); sq += __shfl_xor(sq, 8); sq += __shfl_xor(sq, 16);
          if (seg == 0) ssq_next[(size_t)(brow + ai * 128 + row) * 4 + pn] = sq;
        }
      }
    }
  }
};

struct EpiLruGate {
  static constexpr bool REGMODE = false;
  DI void reg(const AccT&, char*, int, int, int) const {}
  const float* ba; const float* bx; const float* lam; const u16* xc; float* a; float* b;
  struct Pre {};
  DI void pre(Pre&, int, int, int, int) const {}
  DI void operator()(const Pre&, const float* stg, int brow, int pn, int wv, int lane) const {
    const int l32 = lane & 31;
    const int ch = (pn >> 1) * 256 + (pn & 1) * 128 + l32 * 4;
    const f32x4 vba = *(const f32x4*)(ba + ch), vbx = *(const f32x4*)(bx + ch), vl = *(const f32x4*)(lam + ch);
    f32x4 sp;
#pragma unroll
    for (int j = 0; j < 4; ++j) sp[j] = __logf(1.f + __expf(-vl[j]));
#pragma unroll 2
    for (int rp = wv; rp < 32; rp += 8) {
      const int rr = rp * 2 + (lane >> 5), row = brow + rr;
      const size_t idx = (size_t)row * D_ + ch;
      const uint2 xw = *(const uint2*)(xc + idx);
      const float xv[4] = {bf2f((u16)(xw.x & 0xffff)), bf2f((u16)(xw.x >> 16)), bf2f((u16)(xw.y & 0xffff)), bf2f((u16)(xw.y >> 16))};
      const f32x4 ra = *(const f32x4*)(stg + rr * STG_LD + l32 * 4), ia = *(const f32x4*)(stg + rr * STG_LD + 128 + l32 * 4);
      f32x4 av, bv;
#pragma unroll
      for (int j = 0; j < 4; ++j) {
        const float r = sigmoidf(ra[j] + vba[j]), ig = sigmoidf(ia[j] + vbx[j]);
        const float la = -8.f * r * sp[j];
        const float x2 = 2.f * la;
        float mult = sqrtf((x2 > -0.05f) ? -x2 * (1.f + x2 * (0.5f + x2 * (0.16666667f + x2 * 0.041666667f))) : 1.f - __expf(x2));
        if ((row & (S_ - 1)) == 0) mult = 1.f;
        av[j] = __expf(la); bv[j] = mult * ig * xv[j];
      }
      *(f32x4*)(a + idx) = av; *(f32x4*)(b + idx) = bv;
    }
  }
};

constexpr int KLD = 72;
#define MFMA32(a, b, c) __builtin_amdgcn_mfma_f32_32x32x16_bf16((a), (b), (c), 0, 0, 0)

DI int keyoff(int sb, int i, int hf) { return sb * 32 + (i >> 2) * 8 + hf * 4 + (i & 3); }

DI void qk_scores(const u16* Ks, const bf16x8 (&qf)[4], int lane, f32x16 (&s)[2]) {
  const int r = lane & 31, hf = lane >> 5;
#pragma unroll
  for (int sb = 0; sb < 2; ++sb) {
    f32x16 acc = {};
#pragma unroll
    for (int st = 0; st < 4; ++st) {
      const bf16x8 a = *(const bf16x8*)(Ks + (sb * 32 + r) * KLD + st * 16 + hf * 8);
      acc = MFMA32(a, qf[st], acc);
    }
    s[sb] = acc;
  }
}

DI void pv_acc(const u16* Vs, const f32x16 (&p)[2], f32x16 (&o)[2], int lane, unsigned pmask = 0xffffffffu) {
  const int r = lane & 31, hf = lane >> 5;
#pragma unroll
  for (int sb = 0; sb < 2; ++sb)
#pragma unroll
    for (int c = 0; c < 2; ++c) {
      union { bf16x8 v; unsigned u[4]; } pb;
#pragma unroll
      for (int q = 0; q < 4; ++q) pb.u[q] = pack2(p[sb][8 * c + 2 * q], p[sb][8 * c + 2 * q + 1]) & pmask;
#pragma unroll
      for (int db = 0; db < 2; ++db) {
        const u16* vp = Vs + (db * 32 + r) * KLD + sb * 32 + c * 16 + hf * 4;
        union { bf16x8 v; s16x4 h[2]; } a;
        a.h[0] = *(const s16x4*)(vp); a.h[1] = *(const s16x4*)(vp + 8);
        o[db] = MFMA32(a.v, pb.v, o[db]);
      }
    }
}

template <class VF>
DI void softmax_pv(const u16* Vs, f32x16 (&s)[2], float& m, float& l, f32x16 (&o)[2], int lane, VF validf) {
  const int hf = lane >> 5;
  float ls = 0.f;
#pragma unroll
  for (int sb = 0; sb < 2; ++sb)
#pragma unroll
    for (int i = 0; i < 16; ++i) { const float pv = validf(keyoff(sb, i, hf)) ? __builtin_amdgcn_exp2f(s[sb][i]) : 0.f; s[sb][i] = pv; ls += pv; }
  l += ls;
  pv_acc(Vs, s, o, lane);
}

DI void softmax_pv_lane(const u16* Vs, f32x16 (&s)[2], float& m, float& l, f32x16 (&o)[2], int lane, bool lv) {
  const float me = lv ? 0.f : 1e30f;
  float ls = 0.f;
#pragma unroll
  for (int sb = 0; sb < 2; ++sb)
#pragma unroll
    for (int i = 0; i < 16; ++i) { const float pv = __builtin_amdgcn_exp2f(s[sb][i] - me); s[sb][i] = pv; ls += pv; }
  l += ls;
  pv_acc(Vs, s, o, lane);
}

DI unsigned prob_lane(f32x16 (&s)[2], float& l, bool lv) {
  float ls = 0.f;
#pragma unroll
  for (int sb = 0; sb < 2; ++sb)
#pragma unroll
    for (int i = 0; i < 16; ++i) { const float pv = __builtin_amdgcn_exp2f(s[sb][i]); s[sb][i] = pv; ls += pv; }
  l += lv ? ls : 0.f;
  return lv ? 0xffffffffu : 0u;
}
template <class VF>
DI void prob_elem(f32x16 (&s)[2], float& l, int lane, VF validf) {
  const int hf = lane >> 5;
  float ls = 0.f;
#pragma unroll
  for (int sb = 0; sb < 2; ++sb)
#pragma unroll
    for (int i = 0; i < 16; ++i) { const float pv = validf(keyoff(sb, i, hf)) ? __builtin_amdgcn_exp2f(s[sb][i]) : 0.f; s[sb][i] = pv; ls += pv; }
  l += ls;
}

DI void kv_load(int tid, const u16* kb, int kld, const u16* vb, int vld, int key0, uint4& kr, uint4& vr) {
  const int r = tid >> 3, seg = tid & 7;
  kr = *(const uint4*)(kb + (size_t)(key0 + r) * kld + seg * 8);
  vr = *(const uint4*)(vb + (size_t)r * vld + key0 + seg * 8);
}
DI void kv_store(int tid, u16* Ks, u16* Vs, const uint4& kr, const uint4& vr) {
  const int r = tid >> 3, seg = tid & 7;
  *(uint4*)(Ks + r * KLD + seg * 8) = kr;
  *(uint4*)(Vs + r * KLD + seg * 8) = vr;
}

template <class TF>
DI void attn_loop(int tid, const int* list, int cnt, const u16* kb, int kld, const u16* vb, int vld, u16* Ks, u16* Vs, TF f) {
  constexpr int BUFO = 2 * 64 * KLD;
  uint4 k0r, v0r, k1r, v1r;
  if (cnt > 0) kv_load(tid, kb, kld, vb, vld, list[0], k0r, v0r);
  if (cnt > 1) kv_load(tid, kb, kld, vb, vld, list[1], k1r, v1r);
  if (cnt > 0) kv_store(tid, Ks, Vs, k0r, v0r);
  __syncthreads();
  for (int it = 0; it < cnt; it += 2) {
    if (it + 2 < cnt) kv_load(tid, kb, kld, vb, vld, list[it + 2], k0r, v0r);
    f(list[it], Ks, Vs);
    if (it + 1 < cnt) kv_store(tid, Ks + BUFO, Vs + BUFO, k1r, v1r);
    __syncthreads();
    if (it + 1 < cnt) {
      if (it + 3 < cnt) kv_load(tid, kb, kld, vb, vld, list[it + 3], k1r, v1r);
      f(list[it + 1], Ks + BUFO, Vs + BUFO);
      if (it + 2 < cnt) kv_store(tid, Ks, Vs, k0r, v0r);
      __syncthreads();
    }
  }
}

template <class TF>
DI void attn_loop_p2(int tid, const int* list, int cnt, const u16* kb, int kld, const u16* vb, int vld, u16* Ks, TF f) {
  constexpr int BUFO = 2 * 64 * KLD;
  if (cnt <= 0) return;
  uint4 k0r, v0r, k1r, v1r;
  kv_load(tid, kb, kld, vb, vld, list[0], k0r, v0r);
  kv_load(tid, kb, kld, vb, vld, list[1], k1r, v1r);
  kv_store(tid, Ks, Ks + 64 * KLD, k0r, v0r);
  kv_store(tid, Ks + BUFO, Ks + BUFO + 64 * KLD, k1r, v1r);
  __syncthreads();
  for (int it = 0; it < cnt; it += 2) {
    const int base = ((it >> 1) & 1) * 2;
    u16* Ka = Ks + base * BUFO; u16* Kb = Ka + BUFO;
    u16* Na = Ks + (2 - base) * BUFO; u16* Nb = Na + BUFO;
    if (it + 2 < cnt) { kv_load(tid, kb, kld, vb, vld, list[it + 2], k0r, v0r); kv_load(tid, kb, kld, vb, vld, list[it + 3], k1r, v1r); }
    f(list[it], Ka, Ka + 64 * KLD);
    f(list[it + 1], Kb, Kb + 64 * KLD);
    if (it + 2 < cnt) { kv_store(tid, Na, Na + 64 * KLD, k0r, v0r); kv_store(tid, Nb, Nb + 64 * KLD, k1r, v1r); }
    __syncthreads();
  }
}

template <bool keep>
DI void load_q(const u16* qrow, const float* gain, float scale, int lane, bf16x8 (&qf)[4], float (&qn)[32]) {
  const int hf = lane >> 5;
  float v[32]; float ss = 0.f;
#pragma unroll
  for (int st = 0; st < 4; ++st) {
    const uint4 w = *(const uint4*)(qrow + st * 16 + hf * 8);
    const unsigned uu[4] = {w.x, w.y, w.z, w.w};
#pragma unroll
    for (int q = 0; q < 4; ++q) { v[st * 8 + 2 * q] = bf2f((u16)(uu[q] & 0xffff)); v[st * 8 + 2 * q + 1] = bf2f((u16)(uu[q] >> 16)); }
  }
#pragma unroll
  for (int i = 0; i < 32; ++i) ss += v[i] * v[i];
  ss += __shfl_xor(ss, 32);
  const float rs = rsqrtf(ss * (1.f / 64.f) + EPS_);
#pragma unroll
  for (int st = 0; st < 4; ++st) {
    union { bf16x8 v8; unsigned u[4]; } pk;
#pragma unroll
    for (int q = 0; q < 4; ++q) {
      const int d0 = st * 16 + hf * 8 + 2 * q;
      const float a = v[st * 8 + 2 * q] * rs * gain[d0], b = v[st * 8 + 2 * q + 1] * rs * gain[d0 + 1];
      if (keep) { qn[st * 8 + 2 * q] = a; qn[st * 8 + 2 * q + 1] = b; }
      pk.u[q] = pack2(a * scale, b * scale);
    }
    qf[st] = pk.v8;
  }
}

DI void acc_out(f32x16 (&tot)[2], const f32x16 (&o)[2], float w) {
#pragma unroll
  for (int db = 0; db < 2; ++db) tot[db] = tot[db] + o[db] * w;
}
DI void store_out(u16* orow, const f32x16 (&tot)[2], int lane) {
  const int hf = lane >> 5;
#pragma unroll
  for (int db = 0; db < 2; ++db)
#pragma unroll
    for (int gq = 0; gq < 4; ++gq) {
      uint2 w; w.x = pack2(tot[db][gq * 4 + 0], tot[db][gq * 4 + 1]); w.y = pack2(tot[db][gq * 4 + 2], tot[db][gq * 4 + 3]);
      *(uint2*)(orow + db * 32 + gq * 8 + hf * 4) = w;
    }
}

DI void moba_prep(const u16* RAW, const float* kgain, u16* KN, u16* VT, float* KMEAN, char* shm) {
  float* tile = (float*)shm;
  float* part = tile + 256 * 65;
  const int tid = tidx();
  for (int item = bidx(); item < 1024; item += gdim()) {
    const int h = item & 15, n = (item >> 4) & 15, b = item >> 8;
    const int t0 = b * S_ + n * 256;
    {
      const int tk = tid >> 1, half = tid & 1;
      const u16* src = RAW + (size_t)(t0 + tk) * 3072 + 1024 + h * 64 + half * 32;
      float v[32]; float ss = 0.f;
#pragma unroll
      for (int q4 = 0; q4 < 4; ++q4) {
        const uint4 w = *(const uint4*)(src + q4 * 8);
        const unsigned uu[4] = {w.x, w.y, w.z, w.w};
#pragma unroll
        for (int q = 0; q < 4; ++q) { v[q4 * 8 + 2 * q] = bf2f((u16)(uu[q] & 0xffff)); v[q4 * 8 + 2 * q + 1] = bf2f((u16)(uu[q] >> 16)); }
      }
#pragma unroll
      for (int i = 0; i < 32; ++i) ss += v[i] * v[i];
      ss += __shfl_xor(ss, 1);
      const float rs = rsqrtf(ss * (1.f / 64.f) + EPS_);
      u16* dst = KN + (size_t)(t0 + tk) * 1024 + h * 64 + half * 32;
#pragma unroll
      for (int q4 = 0; q4 < 4; ++q4) {
        uint4 w; unsigned uu[4];
#pragma unroll
        for (int q = 0; q < 4; ++q) {
          const int d = half * 32 + q4 * 8 + 2 * q;
          const float a = v[q4 * 8 + 2 * q] * rs * kgain[d], bb = v[q4 * 8 + 2 * q + 1] * rs * kgain[d + 1];
          tile[tk * 65 + d] = a; tile[tk * 65 + d + 1] = bb;
          uu[q] = pack2(a, bb);
        }
        w.x = uu[0]; w.y = uu[1]; w.z = uu[2]; w.w = uu[3];
        *(uint4*)(dst + q4 * 8) = w;
      }
    }
    __syncthreads();
    { const int d = tid & 63, pt = tid >> 6; float s = 0.f;
      for (int i = 0; i < 32; ++i) s += tile[(pt * 32 + i) * 65 + d];
      part[pt * 64 + d] = s; }
    __syncthreads();
    if (tid < 64) { float s = 0.f; for (int i = 0; i < 8; ++i) s += part[i * 64 + tid];
      KMEAN[((size_t)(b * 16 + h) * 16 + n) * 64 + tid] = s * (1.f / 256.f); }
    __syncthreads();
    {
      u16* vt = (u16*)shm;
      const int tk = tid >> 1, half = tid & 1;
      const u16* src = RAW + (size_t)(t0 + tk) * 3072 + 2048 + h * 64 + half * 32;
#pragma unroll
      for (int q4 = 0; q4 < 4; ++q4) {
        const uint4 w = *(const uint4*)(src + q4 * 8);
        unsigned* dp = (unsigned*)(vt + tk * 66 + half * 32 + q4 * 8);
        dp[0] = w.x; dp[1] = w.y; dp[2] = w.z; dp[3] = w.w;
      }
      __syncthreads();
      const int d = tid >> 3, ts = (tid & 7) * 32;
      u16* dst = VT + ((size_t)(b * 1024 + h * 64 + d)) * S_ + n * 256 + ts;
#pragma unroll
      for (int q4 = 0; q4 < 4; ++q4) {
        uint4 w; unsigned uu[4];
#pragma unroll
        for (int q = 0; q < 4; ++q) uu[q] = (unsigned)vt[(ts + q4 * 8 + 2 * q) * 66 + d] | ((unsigned)vt[(ts + q4 * 8 + 2 * q + 1) * 66 + d] << 16);
        w.x = uu[0]; w.y = uu[1]; w.z = uu[2]; w.w = uu[3];
        *(uint4*)(dst + q4 * 8) = w;
      }
    }
    __syncthreads();
  }
}

DI void moba_attn(const u16* RAW, const float* qgain, const u16* KN, const u16* VT, const float* KMEAN, u16* O, char* shm) {
  u16* Ks = (u16*)shm; u16* Vs = Ks + 64 * KLD;
  float* km = (float*)(Ks + 8 * 64 * KLD);
  int* list = (int*)(km + 16 * 64);
  int* misc = list + 64;
  const int tid = tidx(), wv = tid >> 6, lane = tid & 63, r = lane & 31, hf = lane >> 5;
  for (int it0 = bidx(); it0 < 1024; it0 += gdim()) {
    const int rnd = it0 >> 8, idx = it0 & 255, grp = idx >> 6, sub = idx & 63;
    const int own = (rnd == 0) ? 15 - grp : (rnd == 1) ? 8 + grp : (rnd == 2) ? 7 - grp : grp;
    const int b = sub >> 4, h = sub & 15;
    const int pos = own * 256 + wv * 32 + r;
    const size_t tok = (size_t)b * S_ + pos;
    for (int i = tid; i < 1024; i += 512) km[i] = KMEAN[(size_t)(b * 16 + h) * 1024 + i];
    if (tid == 0) misc[0] = 0;
    bf16x8 qf[4]; float qn[32];
    load_q<true>(RAW + tok * 3072 + h * 64, qgain, 0.125f * LOG2E, lane, qf, qn);
    __syncthreads();
    float v0 = -3e38f, v1 = -3e38f, v2 = -3e38f; int i0 = -1, i1 = -1, i2 = -1;
    for (int n = 0; n < own; ++n) {
      float gsum = 0.f;
#pragma unroll
      for (int st = 0; st < 4; ++st)
#pragma unroll
        for (int j = 0; j < 8; ++j) gsum += qn[st * 8 + j] * km[n * 64 + st * 16 + hf * 8 + j];
      gsum += __shfl_xor(gsum, 32);
      if (gsum > v0) { v2 = v1; i2 = i1; v1 = v0; i1 = i0; v0 = gsum; i0 = n; }
      else if (gsum > v1) { v2 = v1; i2 = i1; v1 = gsum; i1 = n; }
      else if (gsum > v2) { v2 = gsum; i2 = n; }
    }
    unsigned mymask = 0;
    if (i0 >= 0) mymask |= 1u << i0;
    if (i1 >= 0) mymask |= 1u << i1;
    if (i2 >= 0) mymask |= 1u << i2;
    unsigned wor = mymask;
#pragma unroll
    for (int o = 1; o < 64; o <<= 1) wor |= (unsigned)__shfl_xor((int)wor, o);
    if (lane == 0) atomicOr((unsigned*)&misc[0], wor);
    __syncthreads();
    if (tid == 0) {
      const unsigned un = (unsigned)misc[0]; int c = 0;
      for (int n = 0; n <= own; ++n) if (n == own || ((un >> n) & 1)) for (int kt = 0; kt < 4; ++kt) list[c++] = n * 256 + kt * 64;
      misc[1] = c;
    }
    __syncthreads();
    const int cnt = misc[1];
    f32x16 o[2] = {}; float m = -1e30f, l = 0.f;
    const int wmax = own * 256 + wv * 32 + 31;
    attn_loop_p2(tid, list, cnt, KN + (size_t)b * S_ * 1024 + h * 64, 1024, VT + (size_t)(b * 1024 + h * 64) * S_, S_, Ks, [&](int key0, const u16* Ks, const u16* Vs) {
      const int n = key0 >> 8;
      const bool need = (n == own) ? (key0 <= wmax) : ((wor >> n) & 1);
      if (need) {
        f32x16 s[2];
        qk_scores(Ks, qf, lane, s);
        unsigned pm = 0xffffffffu;
        if (n != own) pm = prob_lane(s, l, (mymask >> n) & 1);
        else if (key0 + 63 <= wmax - 31) pm = prob_lane(s, l, true);
        else prob_elem(s, l, lane, [&](int ko) { return key0 + ko <= pos; });
        pv_acc(Vs, s, o, lane, pm);
      }
    });
    l += __shfl_xor(l, 32);
    f32x16 tot[2] = {};
    acc_out(tot, o, 1.f / l);
    store_out(O + tok * 1024 + h * 64, tot, lane);
  }
}

DI void lru_conv(const u16* RAW, const float* cw, const float* cb, u16* XC) {
  const int nth = gdim() * 512;
  for (int i = bidx() * 512 + tidx(); i < T_ * 128; i += nth) {
    const int t = i >> 7, c0 = (i & 127) * 8, ts = t & (S_ - 1);
    float acc[8];
#pragma unroll
    for (int j = 0; j < 8; ++j) acc[j] = cb[c0 + j];
#pragma unroll
    for (int k = 0; k < 4; ++k) {
      if (ts - 3 + k >= 0) {
        const uint4 w = *(const uint4*)(RAW + (size_t)(t - 3 + k) * 2048 + c0);
        const unsigned uu[4] = {w.x, w.y, w.z, w.w};
#pragma unroll
        for (int q = 0; q < 4; ++q) {
          acc[2 * q] += cw[k * 1024 + c0 + 2 * q] * bf2f((u16)(uu[q] & 0xffff));
          acc[2 * q + 1] += cw[k * 1024 + c0 + 2 * q + 1] * bf2f((u16)(uu[q] >> 16));
        }
      }
    }
    uint4 w; w.x = pack2(acc[0], acc[1]); w.y = pack2(acc[2], acc[3]); w.z = pack2(acc[4], acc[5]); w.w = pack2(acc[6], acc[7]);
    *(uint4*)(XC + (size_t)t * 1024 + c0) = w;
  }
}

DI void lru_scan1(const float* A, const float* Bv, float* PC, float* HC) {
  const int tid = tidx();
  for (int vb = bidx(); vb < 256; vb += gdim()) {
    const int gi = vb * 512 + tid, cg = gi & 255, c = (gi >> 8) & 127, b = gi >> 15;
    const size_t base = ((size_t)b * S_ + c * 32) * 1024 + cg * 4;
    f32x4 hl = {0.f, 0.f, 0.f, 0.f}, P = {1.f, 1.f, 1.f, 1.f};
#pragma unroll 8
    for (int i = 0; i < 32; ++i) { const f32x4 a = *(const f32x4*)(A + base + (size_t)i * 1024), bb = *(const f32x4*)(Bv + base + (size_t)i * 1024); hl = a * hl + bb; P = P * a; }
    const size_t q = ((size_t)(b * 128 + c)) * 1024 + cg * 4;
    *(f32x4*)(PC + q) = P; *(f32x4*)(HC + q) = hl;
  }
}
DI void lru_scan2(const float* A, const float* Bv, const float* PC, const float* HC, const u16* RAW, u16* HY) {
  const int tid = tidx();
  for (int vb = bidx(); vb < 256; vb += gdim()) {
    const int gi = vb * 512 + tid, cg = gi & 255, c = (gi >> 8) & 127, b = gi >> 15;
    f32x4 h = {0.f, 0.f, 0.f, 0.f};
    {
      int cc = 0;
      for (; cc + 8 <= c; cc += 8) {
        f32x4 Pv[8], Hv[8];
#pragma unroll
        for (int u = 0; u < 8; ++u) { const size_t q = ((size_t)(b * 128 + cc + u)) * 1024 + cg * 4; Pv[u] = *(const f32x4*)(PC + q); Hv[u] = *(const f32x4*)(HC + q); }
#pragma unroll
        for (int u = 0; u < 8; ++u) h = Pv[u] * h + Hv[u];
      }
      for (; cc < c; ++cc) { const size_t q = ((size_t)(b * 128 + cc)) * 1024 + cg * 4; h = *(const f32x4*)(PC + q) * h + *(const f32x4*)(HC + q); }
    }
    const size_t t0 = (size_t)b * S_ + c * 32;
#pragma unroll 8
    for (int i = 0; i < 32; ++i) {
      const size_t t = t0 + i;
      h = *(const f32x4*)(A + t * 1024 + cg * 4) * h + *(const f32x4*)(Bv + t * 1024 + cg * 4);
      const uint2 yw = *(const uint2*)(RAW + t * 2048 + 1024 + cg * 4);
      uint2 w;
      w.x = pack2(h[0] * bf2f((u16)(yw.x & 0xffff)), h[1] * bf2f((u16)(yw.x >> 16)));
      w.y = pack2(h[2] * bf2f((u16)(yw.y & 0xffff)), h[3] * bf2f((u16)(yw.y >> 16)));
      *(uint2*)(HY + t * 1024 + cg * 4) = w;
    }
  }
}

DI void nsa_prep(const u16* RAW, const Params& p, char* scr, char* shm, int mode, int vbid, int vnb) {
  const int tid = tidx();
  const float* gate_b = p.in[20]; const float* ksg = p.in[23]; const float* kwg = p.in[24];
  const float* pos_k = p.in[25]; const float* pos_v = p.in[26];
  u16* KSN = (u16*)(scr + N_KSN); u16* KWN = (u16*)(scr + N_KWN); u16* VST = (u16*)(scr + N_VST); u16* VWT = (u16*)(scr + N_VWT);
  u16* AK = (u16*)(scr + N_AK); u16* AV = (u16*)(scr + N_AV); float* GATES = (float*)(scr + N_GATES);
  if (mode == 2)
  for (int item = vbid; item < 512; item += vnb) {
    const int which = item & 1, g = (item >> 1) & 3, n = (item >> 3) & 15, b = item >> 7;
    const int t0 = b * S_ + n * 256;
    const int kcol = (which ? 2048 : 1536) + g * 64, vcol = (which ? 2304 : 1792) + g * 64;
    const float* gain = which ? kwg : ksg;
    u16* KNo = which ? KWN : KSN; u16* VTo = which ? VWT : VST;
    {
      const int tk = tid >> 1, half = tid & 1;
      const u16* src = RAW + (size_t)(t0 + tk) * 2816 + kcol + half * 32;
      float v[32]; float ss = 0.f;
#pragma unroll
      for (int q4 = 0; q4 < 4; ++q4) {
        const uint4 w = *(const uint4*)(src + q4 * 8);
        const unsigned uu[4] = {w.x, w.y, w.z, w.w};
#pragma unroll
        for (int q = 0; q < 4; ++q) { v[q4 * 8 + 2 * q] = bf2f((u16)(uu[q] & 0xffff)); v[q4 * 8 + 2 * q + 1] = bf2f((u16)(uu[q] >> 16)); }
      }
#pragma unroll
      for (int i = 0; i < 32; ++i) ss += v[i] * v[i];
      ss += __shfl_xor(ss, 1);
      const float rs = rsqrtf(ss * (1.f / 64.f) + EPS_);
      u16* dst = KNo + (size_t)(t0 + tk) * 256 + g * 64 + half * 32;
#pragma unroll
      for (int q4 = 0; q4 < 4; ++q4) {
        unsigned uu[4];
#pragma unroll
        for (int q = 0; q < 4; ++q) { const int d = half * 32 + q4 * 8 + 2 * q; uu[q] = pack2(v[q4 * 8 + 2 * q] * rs * gain[d], v[q4 * 8 + 2 * q + 1] * rs * gain[d + 1]); }
        uint4 w; w.x = uu[0]; w.y = uu[1]; w.z = uu[2]; w.w = uu[3];
        *(uint4*)(dst + q4 * 8) = w;
      }
    }
    {
      u16* vt = (u16*)shm;
      const int tk = tid >> 1, half = tid & 1;
      const u16* src = RAW + (size_t)(t0 + tk) * 2816 + vcol + half * 32;
#pragma unroll
      for (int q4 = 0; q4 < 4; ++q4) {
        const uint4 w = *(const uint4*)(src + q4 * 8);
        unsigned* dp = (unsigned*)(vt + tk * 66 + half * 32 + q4 * 8);
        dp[0] = w.x; dp[1] = w.y; dp[2] = w.z; dp[3] = w.w;
      }
      __syncthreads();
      const int d = tid >> 3, ts = (tid & 7) * 32;
      u16* dst = VTo + ((size_t)(b * 256 + g * 64 + d)) * S_ + n * 256 + ts;
#pragma unroll
      for (int q4 = 0; q4 < 4; ++q4) {
        unsigned uu[4];
#pragma unroll
        for (int q = 0; q < 4; ++q) uu[q] = (unsigned)vt[(ts + q4 * 8 + 2 * q) * 66 + d] | ((unsigned)vt[(ts + q4 * 8 + 2 * q + 1) * 66 + d] << 16);
        uint4 w; w.x = uu[0]; w.y = uu[1]; w.z = uu[2]; w.w = uu[3];
        *(uint4*)(dst + q4 * 8) = w;
      }
      __syncthreads();
    }
  }
  const int nth = vnb * 512, gt = vbid * 512 + tid;
  if (mode == 2)
  for (int i = gt; i < T_ * 48; i += nth) {
    const int t = i / 48, c = i - t * 48;
    GATES[i] = sigmoidf(bf2f(RAW[(size_t)t * 2816 + 2560 + c]) + gate_b[c]);
  }
  if (mode == 1)
  for (int i = gt; i < 4096 * 256; i += nth) {
    const int row = i >> 8, c8 = (i & 255) * 8, ii = c8 >> 6, d = c8 & 63;
    const int n = row & 255, g = (row >> 8) & 3, b = row >> 10;
    uint4 wk = make_uint4(0, 0, 0, 0), wv = wk;
    if (n < 255) {
      const size_t t = (size_t)b * S_ + n * 16 + ii;
      const uint4 rk = *(const uint4*)(RAW + t * 2816 + 1024 + g * 64 + d);
      const uint4 rv = *(const uint4*)(RAW + t * 2816 + 1280 + g * 64 + d);
      const unsigned ku[4] = {rk.x, rk.y, rk.z, rk.w}, vu[4] = {rv.x, rv.y, rv.z, rv.w};
      unsigned ko[4], vo[4];
#pragma unroll
      for (int q = 0; q < 4; ++q) {
        const int e = ii * 64 + d + 2 * q;
        ko[q] = pack2(bf2f((u16)(ku[q] & 0xffff)) + pos_k[e], bf2f((u16)(ku[q] >> 16)) + pos_k[e + 1]);
        vo[q] = pack2(bf2f((u16)(vu[q] & 0xffff)) + pos_v[e], bf2f((u16)(vu[q] >> 16)) + pos_v[e + 1]);
      }
      wk = make_uint4(ko[0], ko[1], ko[2], ko[3]); wv = make_uint4(vo[0], vo[1], vo[2], vo[3]);
    }
    *(uint4*)(AK + (size_t)row * 2048 + c8) = wk;
    *(uint4*)(AV + (size_t)row * 2048 + c8) = wv;
  }
}

DI void nsa_cmp2(const u16* HK, const u16* HV, const float* w2k, const float* w2v, const float* kcg, u16* KCMP, u16* VCMPT) {
  const int tid = tidx(); const int wv = tid >> 6, lane = tid & 63;
  for (int rw = bidx() * 8 + wv; rw < 8192; rw += gdim() * 8) {
    const int which = rw >> 12, row = rw & 4095;
    const u16* hrow = (which ? HV : HK) + (size_t)row * 256;
    const float* w2 = which ? w2v : w2k;
    float acc = 0.f;
#pragma unroll 4
    for (int k0 = 0; k0 < 256; k0 += 8) {
      const uint4 hw = *(const uint4*)(hrow + k0);
      const unsigned uu[4] = {hw.x, hw.y, hw.z, hw.w};
#pragma unroll
      for (int u = 0; u < 4; ++u) {
        acc += bf2f((u16)(uu[u] & 0xffff)) * w2[(k0 + 2 * u) * 64 + lane];
        acc += bf2f((u16)(uu[u] >> 16)) * w2[(k0 + 2 * u + 1) * 64 + lane];
      }
    }
    if (which == 0) {
      float ss = acc * acc;
#pragma unroll
      for (int o = 1; o < 64; o <<= 1) ss += __shfl_xor(ss, o);
      const float rs = rsqrtf(ss * (1.f / 64.f) + EPS_);
      KCMP[(size_t)row * 64 + lane] = f2bf(acc * rs * kcg[lane]);
    } else {
      const int bg = row >> 8, n = row & 255;
      VCMPT[((size_t)bg * 64 + lane) * 256 + n] = f2bf(acc);
    }
  }
}

DI void nsa_attn(const u16* RAW, const Params& p, char* scr, char* shm) {
  const u16* KSN = (const u16*)(scr + N_KSN); const u16* KWN = (const u16*)(scr + N_KWN);
  const u16* VST = (const u16*)(scr + N_VST); const u16* VWT = (const u16*)(scr + N_VWT);
  const u16* KCMP = (const u16*)(scr + N_KCMP); const u16* VCMPT = (const u16*)(scr + N_VCMPT);
  const float* GATES = (const float*)(scr + N_GATES); u16* O = (u16*)(scr + N_O);
  const float* qgain = p.in[21];
  u16* Ks = (u16*)shm; u16* Vs = Ks + 64 * KLD;
  int* list = (int*)(Ks + 4 * 64 * KLD);
  unsigned* selm = (unsigned*)(list + 64);
  unsigned* misc = selm + 128;
  float* invs = (float*)(misc + 4);
  float* totl = invs + 256;
  float* impH = totl;
  const int tid = tidx(), wv = tid >> 6, lane = tid & 63, r = lane & 31, hf = lane >> 5;
  const int hh = wv & 3, qh = wv >> 2;
  for (int it0 = bidx(); it0 < 1024; it0 += gdim()) {
    const int rnd = it0 >> 8, idx = it0 & 255, sub = idx & 15, ci = idx >> 4;
    const int c = (rnd == 0) ? 63 - ci : (rnd == 1) ? 32 + ci : (rnd == 2) ? 31 - ci : ci;
    const int b = sub >> 2, g = sub & 3, h = g * 4 + hh;
    const int ql = qh * 32 + r;
    const int pos = c * 64 + ql;
    const size_t tok = (size_t)b * S_ + pos;
    bf16x8 qf[4]; float qn[32];
    load_q<false>(RAW + tok * 2816 + h * 64, qgain, 0.125f * LOG2E, lane, qf, qn);
    for (int i = tid; i < 4 * 64 * 65; i += 512) impH[i] = 0.f;
    const int ncmp = min(255, 4 * c + 3);
    const int ntile = (ncmp + 63) >> 6;
    if (tid < 64) list[tid] = tid * 64;
    __syncthreads();
    const u16* kcb = KCMP + (size_t)(b * 4 + g) * 256 * 64;
    const u16* vcb = VCMPT + (size_t)(b * 4 + g) * 64 * 256;
    float l = 0.f;
    f32x16 oc[2] = {};
    {
      float* myimp = impH + (hh * 64 + ql) * 65;
      attn_loop(tid, list, ntile, kcb, 64, vcb, 256, Ks, Vs, [&](int key0, const u16* Ks, const u16* Vs) {
        f32x16 s[2];
        qk_scores(Ks, qf, lane, s);
        float ls = 0.f;
#pragma unroll
        for (int sb = 0; sb < 2; ++sb)
#pragma unroll
          for (int i = 0; i < 16; ++i) { const int n = key0 + keyoff(sb, i, hf); const bool v = (n < 255) && (16 * n + 31 <= pos); const float pv = v ? __builtin_amdgcn_exp2f(s[sb][i]) : 0.f; s[sb][i] = pv; ls += pv; }
        l += ls;
        pv_acc(Vs, s, oc, lane);
#pragma unroll
        for (int sb = 0; sb < 2; ++sb)
#pragma unroll
          for (int gi = 0; gi < 4; ++gi) {
            const int j = (key0 >> 2) + sb * 8 + gi * 2 + hf;
            myimp[j] += s[sb][gi * 4] + s[sb][gi * 4 + 1] + s[sb][gi * 4 + 2] + s[sb][gi * 4 + 3];
          }
#pragma unroll
        for (int sb = 0; sb < 2; ++sb)
#pragma unroll
          for (int gi = 0; gi < 4; ++gi) {
            const int j = (key0 >> 2) + sb * 8 + gi * 2 + hf + 1;
            if (j < 64) myimp[j] += s[sb][gi * 4 + 3];
          }
      });
    }
    l += __shfl_xor(l, 32);
    const float invc = (l > 0.f) ? 1.f / l : 0.f;
    if (hf == 0) invs[hh * 64 + ql] = invc;
    __syncthreads();
    {
      unsigned un0 = 0, un1 = 0;
      for (int qq = 0; qq < 8; ++qq) {
        const int q = wv * 8 + qq;
        const int j = lane;
        float v = ((impH[(0 * 64 + q) * 65 + j] * invs[q] + impH[(1 * 64 + q) * 65 + j] * invs[64 + q]) + (impH[(2 * 64 + q) * 65 + j] * invs[128 + q] + impH[(3 * 64 + q) * 65 + j] * invs[192 + q]));
        const bool valid = j <= c;
        const bool forced = (j == 0) || (j == c) || (j == c - 1);
        v = valid ? (forced ? 1e30f : v) : -1e30f;
        int rank = 0;
#pragma unroll
        for (int k = 0; k < 64; ++k) {
          const float vk = __builtin_bit_cast(float, __builtin_amdgcn_readlane(__builtin_bit_cast(int, v), k));
          rank += (vk > v || (vk == v && k < j)) ? 1 : 0;
        }
        const unsigned long long bm = __ballot((rank < 16) && valid);
        if (lane == 0) { selm[q * 2] = (unsigned)bm; selm[q * 2 + 1] = (unsigned)(bm >> 32); }
        un0 |= (unsigned)bm; un1 |= (unsigned)(bm >> 32);
      }
      if (tid == 0) { misc[0] = 0; misc[1] = 0; }
      __syncthreads();
      if (lane == 0) { atomicOr(&misc[0], un0); atomicOr(&misc[1], un1); }
      __syncthreads();
      if (tid == 0) {
        const unsigned long long un = (unsigned long long)misc[0] | ((unsigned long long)misc[1] << 32);
        int cn = 0;
        for (int j = 0; j <= c; ++j) if ((un >> j) & 1) list[cn++] = j * 64;
        misc[2] = cn;
      }
      __syncthreads();
    }
    {
      const float gcv = GATES[tok * 48 + h * 3 + 0] * invc;
#pragma unroll
      for (int db = 0; db < 2; ++db)
#pragma unroll
        for (int i = 0; i < 16; ++i) totl[(db * 16 + i) * 512 + tid] = oc[db][i] * gcv;
    }
    {
      const unsigned long long mym = (unsigned long long)selm[ql * 2] | ((unsigned long long)selm[ql * 2 + 1] << 32);
      unsigned long long wm = mym;
      { unsigned lo = (unsigned)wm, hi = (unsigned)(wm >> 32);
#pragma unroll
        for (int o = 1; o < 32; o <<= 1) { lo |= (unsigned)__shfl_xor((int)lo, o); hi |= (unsigned)__shfl_xor((int)hi, o); }
        wm = (unsigned long long)lo | ((unsigned long long)hi << 32); }
      const int cnt = (int)misc[2];
      f32x16 o[2] = {}; float ms = -1e30f, lsum = 0.f;
      attn_loop(tid, list, cnt, KSN + (size_t)b * S_ * 256 + g * 64, 256, VST + (size_t)(b * 256 + g * 64) * S_, S_, Ks, Vs, [&](int key0, const u16* Ks, const u16* Vs) {
        const int j = key0 >> 6;
        if ((wm >> j) & 1) {
          f32x16 s[2];
          qk_scores(Ks, qf, lane, s);
          unsigned pm = 0xffffffffu;
          if (j != c) pm = prob_lane(s, lsum, (mym >> j) & 1);
          else prob_elem(s, lsum, lane, [&](int ko) { return key0 + ko <= pos; });
          pv_acc(Vs, s, o, lane, pm);
        }
      });
      lsum += __shfl_xor(lsum, 32);
      { const float w = GATES[tok * 48 + h * 3 + 1] / lsum;
#pragma unroll
      for (int db = 0; db < 2; ++db)
#pragma unroll
        for (int i = 0; i < 16; ++i) totl[(db * 16 + i) * 512 + tid] += o[db][i] * w; }
    }
    {
      const int j0 = max(0, c - 8);
      if (tid < 16) list[tid] = (j0 + tid) * 64;
      __syncthreads();
      f32x16 o[2] = {}; float mw = -1e30f, lsum = 0.f;
      attn_loop(tid, list, c - j0 + 1, KWN + (size_t)b * S_ * 256 + g * 64, 256, VWT + (size_t)(b * 256 + g * 64) * S_, S_, Ks, Vs, [&](int key0, const u16* Ks, const u16* Vs) {
        f32x16 s[2];
        qk_scores(Ks, qf, lane, s);
        const int jt = key0 >> 6;
        if (jt > c - 8 && jt < c) (void)prob_lane(s, lsum, true);
        else prob_elem(s, lsum, lane, [&](int ko) { const int kp = key0 + ko; return (kp <= pos) && (kp > pos - 512); });
        pv_acc(Vs, s, o, lane);
      });
      lsum += __shfl_xor(lsum, 32);
      { const float w = GATES[tok * 48 + h * 3 + 2] / lsum;
#pragma unroll
      for (int db = 0; db < 2; ++db)
#pragma unroll
        for (int i = 0; i < 16; ++i) o[db][i] = totl[(db * 16 + i) * 512 + tid] + o[db][i] * w; }
      store_out(O + tok * 1024 + h * 64, o, lane);
    }
    __syncthreads();
  }
}

DI void op_init(const Params& p, char* shm) {
  const float* x = p.in[0];
  u16* HB = (u16*)(p.ws + OFF_HB); float* SSQ = (float*)(p.ws + OFF_SSQ);
  const int tid = tidx(); const int wv = tid >> 6, lane = tid & 63;
  for (int row = bidx() * 8 + wv; row < T_; row += gdim() * 8) {
    float ss = 0.f;
#pragma unroll
    for (int i = 0; i < 4; ++i) {
      const int col = (i * 64 + lane) * 4;
      const float4 v = *(const float4*)(x + (size_t)row * D_ + col);
      ss += v.x * v.x + v.y * v.y + v.z * v.z + v.w * v.w;
      uint2 w; w.x = pack2(v.x, v.y); w.y = pack2(v.z, v.w);
      *(uint2*)(HB + (size_t)row * D_ + col) = w;
    }
#pragma unroll
    for (int o = 1; o < 64; o <<= 1) ss += __shfl_xor(ss, o);
    if (lane < 4) SSQ[(size_t)row * 4 + lane] = (lane == 0) ? ss : 0.f;
  }
  convert_layer(p, 0, shm, (int)blockIdx.x, (int)gridDim.x, 1);
}

template <int OPC, int KINDC>
DI void run_op(const Params& p, int L, int op_rt, char* shm) {
  const int op = (OPC >= 0) ? OPC : op_rt;
  const int kind = (KINDC >= 0) ? KINDC : L % 3, j = L / 3;
  char* ws = p.ws;
  asm volatile("" : "+s"(ws));
  char* scr = ws + OFF_SCR;
  u16* WT = (u16*)(ws + (size_t)(L & 1) * WT_BYTES);
  u16* HB = (u16*)(ws + OFF_HB); float* SSQ = (float*)(ws + OFF_SSQ);
  u16* HID = (u16*)scr;
  switch (op) {
    case OP_INIT: op_init(p, shm); break;
    case OP_UP1: case OP_UP2: {
      const int w = (op == OP_UP1) ? 0 : 2;
      GemmArgs g{HB, D_, WT + (w ? W_UP2 : W_UP1), D_, T_, 2 * F_, D_, -1, -1};
      gemm_phase(g, EpiSwiglu{HID, SSQ + (size_t)w * SSQ_STRIDE}, shm);
      if (op == OP_UP1) { if (L == 0) convert_on_idle(p, 0, shm, (T_ / 256) * (2 * F_ / 256), 2); }
      else convert_on_idle(p, L + 1, shm, (T_ / 256) * (2 * F_ / 256), 3);
    } break;
    case OP_DN1: case OP_DN2: {
      const bool first = (op == OP_DN1);
      GemmArgs g{HID, F_, WT + (first ? W_DN1 : W_DN2), F_, T_, D_, F_, -1, -1};
      float* nx = first ? SSQ + SSQ_STRIDE : (L < 3 ? SSQ : nullptr);
      if (PROBE_DUP & 64) { gemm_phase(g, EpiStore{(u16*)(scr + 100 * MB), D_, nullptr, 1 << 30}, shm); __syncthreads(); }
      gemm_phase(g, EpiResid{(!first && L == 3) ? p.out : nullptr, HB, nx, 0.5f}, shm);
    } break;
    case OP_IN: {
      const int N = (kind == 0) ? 3072 : (kind == 1) ? 2048 : 2816;
      GemmArgs g{HB, D_, WT + W_MIN, D_, T_, N, D_, -1, -1};
      if (kind == 0) gemm_phase(g, EpiMobaIn{(u16*)scr, SSQ + SSQ_STRIDE, p.in[8] + j * 64, (u16*)(scr + A_KN), (u16*)(scr + A_VT), (float*)(scr + A_KMEAN)}, shm);
      else gemm_phase(g, EpiStore{(u16*)scr, N, SSQ + SSQ_STRIDE, (kind == 1) ? 1024 : (1 << 30)}, shm);
    } break;
    case OP_OUT: {
      const u16* Oa = (const u16*)(scr + L_HY);
      GemmArgs g{Oa, D_, WT + W_MOUT, D_, T_, D_, D_, -1, -1};
      if (PROBE_DUP & 64) { gemm_phase(g, EpiStore{(u16*)(scr + 100 * MB), D_, nullptr, 1 << 30}, shm); __syncthreads(); }
      gemm_phase(g, EpiResid{nullptr, HB, SSQ + 2 * SSQ_STRIDE, 1.0f}, shm);
    } break;
    case OP_M1:
      if (kind == 0) moba_prep((const u16*)scr, p.in[8] + j * 64, (u16*)(scr + A_KN), (u16*)(scr + A_VT), (float*)(scr + A_KMEAN), shm);
      else if (kind == 1) lru_conv((const u16*)scr, p.in[11], p.in[12], (u16*)(scr + L_XC));
      else nsa_prep((const u16*)scr, p, scr, shm, 1, (int)blockIdx.x, (int)gridDim.x);
      break;
    case OP_M2:
      if (kind == 0) moba_attn((const u16*)scr, p.in[7] + j * 64, (const u16*)(scr + A_KN), (const u16*)(scr + A_VT), (const float*)(scr + A_KMEAN), (u16*)(scr + A_O), shm);
      else if (kind == 1) {
        GemmArgs g{(const u16*)(scr + L_XC), D_, WT + W_EXT, 256, T_, 2048, 256, 1, -1};
        gemm_phase(g, EpiLruGate{p.in[14], p.in[16], p.in[17], (const u16*)(scr + L_XC), (float*)(scr + L_A), (float*)(scr + L_B)}, shm);
      } else {
        GemmArgs g1{(const u16*)(scr + N_AK), 2048, WT + W_EXT, 2048, 8192, 256, 2048, -1, 4};
        gemm_phase(g1, EpiStore{(u16*)(scr + N_HK), 256, nullptr, 0}, shm);
        { const int nb = (int)gridDim.x, bid = (int)blockIdx.x;
          if (nb > 32) { if (bid >= 32) nsa_prep((const u16*)scr, p, scr, shm, 2, bid - 32, nb - 32); }
          else nsa_prep((const u16*)scr, p, scr, shm, 2, bid, nb); }
      }
      break;
    case OP_M3:
      if (kind == 1) lru_scan1((const float*)(scr + L_A), (const float*)(scr + L_B), (float*)(ws + OFF_PC), (float*)(ws + OFF_HC));
      else if (kind == 2) nsa_cmp2((const u16*)(scr + N_HK), (const u16*)(scr + N_HV), p.in[28], p.in[30], p.in[22], (u16*)(scr + N_KCMP), (u16*)(scr + N_VCMPT));
      break;
    case OP_M4:
      if (kind == 1) lru_scan2((const float*)(scr + L_A), (const float*)(scr + L_B), (const float*)(ws + OFF_PC), (const float*)(ws + OFF_HC), (const u16*)scr, (u16*)(scr + L_HY));
      else if (kind == 2) nsa_attn((const u16*)scr, p, scr, shm);
      break;
  }
}

#if MEGA
constexpr size_t OFF_BAR = 133 * MB;
constexpr int LDS_ST = 143360 - 32;
DI unsigned ld_agent(const unsigned* p) { return __hip_atomic_load(p, __ATOMIC_RELAXED, __HIP_MEMORY_SCOPE_AGENT); }
DI unsigned add_agent(unsigned* p) { return __hip_atomic_fetch_add(p, 1u, __ATOMIC_RELAXED, __HIP_MEMORY_SCOPE_AGENT); }
DI unsigned xcc_id() { return (unsigned)__builtin_amdgcn_s_getreg((3 << 11) | 20) & 0xFu; }
DI void bar_post(unsigned* bar) { if (tidx() == 0) (void)add_agent(&bar[1024 + 32 * xcc_id()]); }
DI void bar_setup(unsigned* bar, char* shm) {
  if (tidx() == 0) {
    const unsigned x = xcc_id(); unsigned nloc = 1, nx = 0;
    for (unsigned j = 0; j < 16; ++j) { const unsigned c = ld_agent(&bar[1024 + 32 * j]); nx += (c > 0u) ? 1u : 0u; if (j == x) nloc = c; }
    volatile unsigned* st = (volatile unsigned*)(shm + LDS_ST);
    st[0] = nloc; st[1] = nx; st[2] = x;
  }
  __syncthreads();
}
DI void grid_bar(unsigned* bar, char* shm) {
  asm volatile("s_waitcnt vmcnt(0)" ::: "memory");
  __syncthreads();
  if (tidx() == 0) {
    volatile unsigned* st = (volatile unsigned*)(shm + LDS_ST);
    const unsigned nloc = st[0], nx = st[1], x = st[2];
    const unsigned old = add_agent(&bar[32 * x]);
    const unsigned gen = old / nloc;
    if (old + 1u == (gen + 1u) * nloc) {
      __builtin_amdgcn_fence(__ATOMIC_RELEASE, "agent");
      asm volatile("s_waitcnt vmcnt(0)" ::: "memory");
      const unsigned og = add_agent(&bar[1536]);
      const unsigned tg = og / nx;
      if (og + 1u == (tg + 1u) * nx) (void)add_agent(&bar[1568]);
      else while (ld_agent(&bar[1568]) == tg) __builtin_amdgcn_s_sleep(1);
      __builtin_amdgcn_fence(__ATOMIC_ACQUIRE, "agent");
      (void)add_agent(&bar[512 + 32 * x]);
      asm volatile("s_waitcnt vmcnt(0)" ::: "memory");
    } else {
      while (ld_agent(&bar[512 + 32 * x]) == gen) __builtin_amdgcn_s_sleep(1);
      __builtin_amdgcn_fence(__ATOMIC_ACQUIRE, "agent");
      asm volatile("s_waitcnt vmcnt(0)" ::: "memory");
    }
  }
  __syncthreads();
}
typedef const __attribute__((address_space(4))) Params* KParams;
template <int OPC, int KINDC, bool SYNC>
DI void run_k(int L, char* shm) {
#if defined(__HIP_DEVICE_COMPILE__)
  KParams kp = (KParams)__builtin_amdgcn_kernarg_segment_ptr();
  asm volatile("" : "+s"(kp));
  const Params p = *kp;
  run_op<OPC, KINDC>(p, L, OPC, shm);
  {
    constexpr bool isA = (OPC == OP_UP1 || OPC == OP_UP2);
    constexpr bool isB = (OPC == OP_M2 && KINDC == 0) || (OPC == OP_M4 && KINDC == 2);
    constexpr bool isC = (OPC == OP_IN);
    constexpr bool isD = (OPC == OP_M1) || (OPC == OP_M3) || (OPC == OP_M2 && KINDC != 0) || (OPC == OP_M4 && KINDC == 1);
    if constexpr (((PROBE_DUP & 1) && isA) || ((PROBE_DUP & 2) && isB) || ((PROBE_DUP & 4) && isC) || ((PROBE_DUP & 8) && isD)) {
      __syncthreads();
      run_op<OPC, KINDC>(p, L, OPC, shm);
    }
  }
  if (SYNC) grid_bar((unsigned*)(p.ws + OFF_BAR), shm);
#endif
}
template <int L>
DI void run_layer(char* shm) {
  constexpr int kind = L % 3;
  run_k<OP_UP1, kind, true>(L, shm);
  run_k<OP_DN1, kind, true>(L, shm);
  run_k<OP_IN, kind, true>(L, shm);
  if constexpr (kind != 0) run_k<OP_M1, kind, true>(L, shm);
  run_k<OP_M2, kind, true>(L, shm);
  if constexpr (kind != 0) {
    run_k<OP_M3, kind, true>(L, shm);
    run_k<OP_M4, kind, true>(L, shm);
  }
  run_k<OP_OUT, kind, true>(L, shm);
  run_k<OP_UP2, kind, true>(L, shm);
  run_k<OP_DN2, kind, (L < 3)>(L, shm);
}
__global__ void __launch_bounds__(512) mega(Params pdummy, int lo, int hi, int coop) {
  extern __shared__ __attribute__((aligned(16))) char shm[];
  {
    KParams kp = (KParams)__builtin_amdgcn_kernarg_segment_ptr();
    bar_post((unsigned*)(kp->ws + OFF_BAR));
  }
  run_k<OP_INIT, -1, false>(0, shm);
  cg::this_grid().sync();
  {
    KParams kp = (KParams)__builtin_amdgcn_kernarg_segment_ptr();
    bar_setup((unsigned*)(kp->ws + OFF_BAR), shm);
  }
  run_layer<0>(shm);
  run_layer<1>(shm);
  run_layer<2>(shm);
  run_layer<3>(shm);
}
#endif
template <int OPC, int KINDC>
__global__ void __launch_bounds__(512) op_kernel(Params p, int L) {
  extern __shared__ __attribute__((aligned(16))) char shm[];
  run_op<OPC, KINDC>(p, L, OPC, shm);
}
template <int OPC, int KINDC>
static void launch_k(const Params& p, int L, int grid, size_t lds, hipStream_t stream) {
  static bool init = false;
  if (!init) { (void)hipFuncSetAttribute((const void*)op_kernel<OPC, KINDC>, hipFuncAttributeMaxDynamicSharedMemorySize, (int)lds); init = true; }
  op_kernel<OPC, KINDC><<<grid, 512, lds, stream>>>(p, L);
}
template <int OPC>
static void launch_op(const Params& p, int L, int grid, size_t lds, hipStream_t stream) {
  if constexpr (OPC == OP_IN || (OPC >= OP_M1 && OPC <= OP_M4)) {
    const int kind = L % 3;
    if (kind == 0) launch_k<OPC, 0>(p, L, grid, lds, stream);
    else if (kind == 1) launch_k<OPC, 1>(p, L, grid, lds, stream);
    else launch_k<OPC, 2>(p, L, grid, lds, stream);
  } else launch_k<OPC, -1>(p, L, grid, lds, stream);
}

extern "C" void kernel_launch(void* const* d_in, const int* in_sizes, int n_in, void* d_out, int out_size, void* d_ws, size_t ws_size,
                              hipStream_t stream) {
  constexpr size_t kDynLds = 140 * 1024;
  static int grid_blocks = 0;
  if (!grid_blocks) {
    int dev = 0, cus = 0;
    (void)hipGetDevice(&dev);
    (void)hipDeviceGetAttribute(&cus, hipDeviceAttributeMultiprocessorCount, dev);
#if MEGA
    (void)hipFuncSetAttribute((const void*)mega, hipFuncAttributeMaxDynamicSharedMemorySize, (int)kDynLds);
#endif
    grid_blocks = cus * 1;
  }
  Params p{};
  for (int i = 0; i < 32; ++i) p.in[i] = (const float*)d_in[i];
  p.out = (float*)d_out; p.ws = (char*)d_ws;
  int n = 0;
  p.prog[n++] = (0 << 4) | OP_INIT;
  for (int L = 0; L < 4; ++L) {
    const int kind = L % 3;
    p.prog[n++] = (L << 4) | OP_UP1; p.prog[n++] = (L << 4) | OP_DN1; p.prog[n++] = (L << 4) | OP_IN;
    p.prog[n++] = (L << 4) | OP_M1; p.prog[n++] = (L << 4) | OP_M2;
    if (kind != 0) { p.prog[n++] = (L << 4) | OP_M3; p.prog[n++] = (L << 4) | OP_M4; }
    p.prog[n++] = (L << 4) | OP_OUT; p.prog[n++] = (L << 4) | OP_UP2; p.prog[n++] = (L << 4) | OP_DN2;
  }
  p.nprog = n;
#if MEGA
  int lo = 0, hi = n, coop = 1;
  (void)hipMemsetAsync((char*)d_ws + OFF_BAR, 0, 8192, stream);
  void* args[] = {&p, &lo, &hi, &coop};
  hipError_t e = hipLaunchCooperativeKernel((void*)mega, dim3(grid_blocks), dim3(512), args, kDynLds, stream);
  if (e != hipSuccess) fprintf(stderr, "cooperative launch failed: %s (grid %d)\n", hipGetErrorString(e), grid_blocks);
#else
  for (int i = 0; i < n; ++i) {
    const int L = p.prog[i] >> 4, op = p.prog[i] & 15;
    switch (op) {
      case OP_INIT: launch_op<OP_INIT>(p, L, grid_blocks, kDynLds, stream); break;
      case OP_UP1: launch_op<OP_UP1>(p, L, grid_blocks, kDynLds, stream); break;
      case OP_DN1: launch_op<OP_DN1>(p, L, grid_blocks, kDynLds, stream); break;
      case OP_IN: launch_op<OP_IN>(p, L, grid_blocks, kDynLds, stream); break;
      case OP_M1: launch_op<OP_M1>(p, L, grid_blocks, kDynLds, stream); break;
      case OP_M2: launch_op<OP_M2>(p, L, grid_blocks, kDynLds, stream); break;
      case OP_M3: launch_op<OP_M3>(p, L, grid_blocks, kDynLds, stream); break;
      case OP_M4: launch_op<OP_M4>(p, L, grid_blocks, kDynLds, stream); break;
      case OP_OUT: launch_op<OP_OUT>(p, L, grid_blocks, kDynLds, stream); break;
      case OP_UP2: launch_op<OP_UP2>(p, L, grid_blocks, kDynLds, stream); break;
      case OP_DN2: launch_op<OP_DN2>(p, L, grid_blocks, kDynLds, stream); break;
    }
  }
#endif
}
```

```cpp
#include <hip/hip_runtime.h>
#include <hip/hip_cooperative_groups.h>
#include <stdint.h>
#include <cstdio>
namespace cg = cooperative_groups;

typedef unsigned short u16;
typedef short bf16x8 __attribute__((ext_vector_type(8)));
typedef short s16x4 __attribute__((ext_vector_type(4)));
typedef float f32x4 __attribute__((ext_vector_type(4)));
typedef float f32x16 __attribute__((ext_vector_type(16)));
#define DI __device__ __forceinline__

constexpr int T_ = 16384, S_ = 4096, D_ = 1024, F_ = 2816;
constexpr float EPS_ = 1e-6f;
constexpr float LOG2E = 1.4426950408889634f;

#ifndef PROBE_DUP
#define PROBE_DUP 0
#endif
#ifndef MEGA
#define MEGA 1
#endif

constexpr size_t MB = 1024 * 1024;
constexpr size_t WT_BYTES = 48 * MB;
constexpr size_t OFF_HB = 96 * MB;
constexpr size_t OFF_SSQ = 128 * MB;
constexpr size_t OFF_PC = 44 * MB;
constexpr size_t OFF_HC = 46 * MB;
constexpr size_t OFF_SCR = 134 * MB;
constexpr size_t SSQ_STRIDE = (size_t)T_ * 4;
constexpr size_t W_UP1 = 0, W_DN1 = W_UP1 + 5632 * 1024, W_UP2 = W_DN1 + 1024 * 2816, W_DN2 = W_UP2 + 5632 * 1024,
                 W_MIN = W_DN2 + 1024 * 2816, W_MOUT = W_MIN + 3072 * 1024, W_EXT = W_MOUT + 1024 * 1024;
constexpr size_t A_RAW = 0, A_KN = 104 * MB, A_VT = 136 * MB, A_O = 224 * MB, A_KMEAN = 200 * MB;
constexpr size_t L_RAW = 0, L_XC = 64 * MB, L_A = 96 * MB, L_B = 160 * MB, L_HY = 224 * MB;
constexpr size_t N_RAW = 0, N_KSN = 96 * MB, N_KWN = 104 * MB, N_VST = 112 * MB, N_VWT = 120 * MB, N_AK = 128 * MB,
                 N_AV = 144 * MB, N_HK = 162 * MB, N_HV = 164 * MB, N_KCMP = 166 * MB, N_VCMPT = 167 * MB, N_GATES = 168 * MB,
                 N_O = 224 * MB;

enum { OP_INIT = 0, OP_UP1, OP_DN1, OP_IN, OP_M1, OP_M2, OP_M3, OP_M4, OP_OUT, OP_UP2, OP_DN2 };

struct Params {
  const float* in[32];
  float* out;
  char* ws;
  int nprog;
  int pad0;
  unsigned char prog[64];
};

typedef __bf16 bf16x2_t __attribute__((ext_vector_type(2)));
typedef float f32x2_t __attribute__((ext_vector_type(2)));
DI unsigned pack2(float a, float b) { f32x2_t f = {a, b}; bf16x2_t h = __builtin_convertvector(f, bf16x2_t); return __builtin_bit_cast(unsigned, h); }
DI u16 f2bf(float x) { return (u16)(pack2(x, 0.f) & 0xffffu); }
DI float bf2f(u16 v) { return __uint_as_float(((unsigned)v) << 16); }
DI float gelu_t(float x) { float u = 1.5957691216057308f * (x + 0.044715f * x * x * x); return x * __builtin_amdgcn_rcpf(1.f + __expf(-u)); }
DI float sigmoidf(float x) { return __builtin_amdgcn_rcpf(1.f + __expf(-x)); }
DI int bidx() { int t = blockIdx.x; asm volatile("" : "+s"(t)); return t; }
DI int gdim() { int t = gridDim.x; asm volatile("" : "+s"(t)); return t; }
DI int tidx() { int t = threadIdx.x; asm volatile("" : "+v"(t)); return t; }

DI void conv_job(const float* src, const float* src2, int ld, int K, int R, int nvalid, int kind, const float* g, u16* dst, char* shm, int vbid, int vnb) {
  float* tile = (float*)shm;
  const int ntk = K / 64, ntr = R / 64, tid = tidx();
  for (int t = vbid; t < ntr * ntk; t += vnb) {
    const int tr = t / ntk, tk = t % ntk, r0 = tr * 64, k0 = tk * 64;
    const float* sp = src; int col0 = r0, nv = nvalid - r0, sld = ld;
    if (kind == 1) { int tile256 = r0 >> 8, within = r0 & 255, half = within >> 7, c = within & 127; col0 = half * 2816 + tile256 * 128 + c; nv = 64; }
    else if (kind == 2) { int pn = r0 >> 8, within = r0 & 255, half = within >> 7, c = within & 127; sp = (half ? src2 : src) + (size_t)(pn >> 1) * 65536; col0 = (pn & 1) * 128 + c; nv = 64; sld = 256; }
    {
      const int kk = tid >> 4, c4 = (tid & 15) * 4;
#pragma unroll
      for (int ps = 0; ps < 2; ++ps) {
        const int k = kk + ps * 32;
        float4 v = make_float4(0.f, 0.f, 0.f, 0.f);
        if (c4 < nv) v = *(const float4*)(sp + (size_t)(k0 + k) * sld + col0 + c4);
        const float gg = g ? g[k0 + k] : 1.f;
        tile[k * 65 + c4 + 0] = v.x * gg; tile[k * 65 + c4 + 1] = v.y * gg; tile[k * 65 + c4 + 2] = v.z * gg; tile[k * 65 + c4 + 3] = v.w * gg;
      }
    }
    __syncthreads();
    {
      const int n = tid >> 3, ks = (tid & 7) * 8;
      uint4 w;
      w.x = pack2(tile[(ks + 0) * 65 + n], tile[(ks + 1) * 65 + n]);
      w.y = pack2(tile[(ks + 2) * 65 + n], tile[(ks + 3) * 65 + n]);
      w.z = pack2(tile[(ks + 4) * 65 + n], tile[(ks + 5) * 65 + n]);
      w.w = pack2(tile[(ks + 6) * 65 + n], tile[(ks + 7) * 65 + n]);
      *(uint4*)(dst + (size_t)(r0 + n) * K + k0 + ks) = w;
    }
    __syncthreads();
  }
}

DI void convert_layer(const Params& p, int L, char* shm, int vbid, int vnb, int mask) {
  if (L >= 4) return;
  const int kind = L % 3, j = L / 3;
  u16* WT = (u16*)(p.ws + (size_t)(L & 1) * WT_BYTES);
  const float* ng = p.in[1] + (size_t)L * 3 * 1024;
  if (mask & 1) conv_job(p.in[2] + (size_t)L * 1024 * 5632, nullptr, 5632, 1024, 5632, 5632, 1, ng, WT + W_UP1, shm, vbid, vnb);
  if (!(mask & 2)) return;
  conv_job(p.in[3] + (size_t)L * 2816 * 1024, nullptr, 1024, 2816, 1024, 1024, 0, nullptr, WT + W_DN1, shm, vbid, vnb);
  conv_job(p.in[4] + (size_t)L * 1024 * 5632, nullptr, 5632, 1024, 5632, 5632, 1, ng + 2048, WT + W_UP2, shm, vbid, vnb);
  conv_job(p.in[5] + (size_t)L * 2816 * 1024, nullptr, 1024, 2816, 1024, 1024, 0, nullptr, WT + W_DN2, shm, vbid, vnb);
  if (kind == 0) {
    conv_job(p.in[6] + (size_t)j * 1024 * 3072, nullptr, 3072, 1024, 3072, 3072, 0, ng + 1024, WT + W_MIN, shm, vbid, vnb);
    conv_job(p.in[9] + (size_t)j * 1024 * 1024, nullptr, 1024, 1024, 1024, 1024, 0, nullptr, WT + W_MOUT, shm, vbid, vnb);
  } else if (kind == 1) {
    conv_job(p.in[10], nullptr, 2048, 1024, 2048, 2048, 0, ng + 1024, WT + W_MIN, shm, vbid, vnb);
    conv_job(p.in[18], nullptr, 1024, 1024, 1024, 1024, 0, nullptr, WT + W_MOUT, shm, vbid, vnb);
    conv_job(p.in[13], p.in[15], 256, 256, 2048, 2048, 2, nullptr, WT + W_EXT, shm, vbid, vnb);
  } else {
    conv_job(p.in[19], nullptr, 2608, 1024, 2816, 2608, 0, ng + 1024, WT + W_MIN, shm, vbid, vnb);
    conv_job(p.in[31], nullptr, 1024, 1024, 1024, 1024, 0, nullptr, WT + W_MOUT, shm, vbid, vnb);
    conv_job(p.in[27], nullptr, 256, 2048, 256, 256, 0, nullptr, WT + W_EXT, shm, vbid, vnb);
    conv_job(p.in[29], nullptr, 256, 2048, 256, 256, 0, nullptr, WT + W_EXT + 256 * 2048, shm, vbid, vnb);
  }
}
DI void convert_on_idle(const Params& p, int L, char* shm, int ntiles, int mask) {
  const int nb = (int)gridDim.x, bid = (int)blockIdx.x;
  const int rem = __builtin_amdgcn_readfirstlane(ntiles % nb);
  if (rem == 0) convert_layer(p, L, shm, bid, nb, mask);
  else if (bid >= rem) convert_layer(p, L, shm, bid - rem, nb - rem, mask);
}

constexpr int STG_LD = 260;
constexpr int BM = 256, BK = 64, HALF = 128, NXCD = 8, WGM = 8, HT = HALF * BK, SHM_B = 8 * HT * 2;

DI int lds_byte(int r, int c) {
  int st = (r >> 4) * 2 + (c >> 5), rr = r & 15, cc = c & 31, ob = rr * 64 + cc * 2;
  return st * 1024 + (ob ^ (((ob >> 9) & 1) << 5));
}
DI void stage_rc(int b, int& R, int& C) {
  int st = b / 1024, sb = b % 1024, swz = sb ^ (((sb >> 9) & 1) << 5);
  R = (st >> 1) * 16 + swz / 64; C = (st & 1) * 32 + (swz % 64) / 2;
}

DI void glds16(const void* sbase, unsigned voff, unsigned lds_addr) {
  unsigned keep;
  asm volatile("s_mov_b32 %0, m0\n\ts_mov_b32 m0, %3\n\ts_nop 0\n\tglobal_load_lds_dwordx4 %1, %2\n\ts_mov_b32 m0, %0"
               : "=&s"(keep) : "v"(voff), "s"(sbase), "s"(lds_addr) : "memory");
}
struct GemmArgs { const u16* A; int lda; const u16* Bt; int ldb; int M, N, K; int a_pn_shift; int b_pm_shift; };

template <class Epi>
DI void gemm_phase(const GemmArgs& g, const Epi& epi, char* shmc) {
  u16* shm = (u16*)shmc;
  const int tid_ = tidx();
  const int lda = g.lda, ldb = g.ldb, K = g.K;
#define SA(b, h) (shm + ((b)*4 + (h)) * HT)
#define SB(b, h) (shm + ((b)*4 + 2 + (h)) * HT)
#define STAGE(P, BASE, LD, br, kt)                                                                                  \
  do {                                                                                                              \
    const u16* _ub = (BASE) + ((long)(br) * (LD) + (long)(kt)*BK);                                                  \
    const unsigned _la = lds0 + (unsigned)((char*)(P) - shmc);     \
    glds16(_ub, so_##LD[0], _la);                                                                                   \
    glds16(_ub, so_##LD[1], _la + 8192u);                                                                           \
  } while (0)
#define LDA(dst, b, h)                                                                                              \
  for (int m = 0; m < 4; ++m) for (int k = 0; k < 2; ++k)                                                           \
    dst[m][k] = *reinterpret_cast<const bf16x8*>((char*)SA(b, h) + lds_byte(wr * 64 + m * 16 + fr, k * 32 + fq * 8))
#define LDB(dst, b, h)                                                                                              \
  for (int n = 0; n < 2; ++n) for (int k = 0; k < 2; ++k)                                                           \
    dst[n][k] = *reinterpret_cast<const bf16x8*>((char*)SB(b, h) + lds_byte(wc * 32 + n * 16 + fr, k * 32 + fq * 8))
#define MMA(ai, bj, At_, Bt_)                                                                                       \
  do {                                                                                                              \
    __builtin_amdgcn_s_setprio(1);                                                                                  \
    for (int m = 0; m < 4; ++m) for (int n = 0; n < 2; ++n) for (int k = 0; k < 2; ++k)                             \
      acc[ai][bj][m][n] = __builtin_amdgcn_mfma_f32_16x16x32_bf16(Bt_[n][k], At_[m][k], acc[ai][bj][m][n], 0, 0, 0); \
    __builtin_amdgcn_s_setprio(0);                                                                                  \
  } while (0)
#define WAIT_V(n) asm volatile("s_waitcnt vmcnt(" #n ")" ::: "memory")
#define WAIT_L(n) asm volatile("s_waitcnt lgkmcnt(" #n ")" ::: "memory")
#define BAR __builtin_amdgcn_s_barrier()
#define SCHED __builtin_amdgcn_sched_barrier(0)

  const int nM = g.M / BM, nN = g.N / BM, nwg = nM * nN;
  const int wid = tid_ >> 6, lane = tid_ & 63, wr = wid >> 2, wc = wid & 3, fr = lane & 15, fq = lane >> 4;
  int nt = K / BK;
  asm volatile("" : "+s"(nt));
  const unsigned lds0 = (unsigned)__builtin_amdgcn_readfirstlane((int)((unsigned)(size_t)(__attribute__((address_space(3))) char*)shmc + (unsigned)(tid_ & ~63) * 16u));
  unsigned so_lda[2], so_ldb[2];
  for (int _i = 0; _i < 2; ++_i) { int _r, _c; stage_rc(tid_ * 16 + _i * 8192, _r, _c); so_lda[_i] = (unsigned)(_r * lda + _c) * 2u; so_ldb[_i] = (unsigned)(_r * ldb + _c) * 2u; }
#define TILE_COORDS(tile_, pm_, pn_)                                                                               \
  do {                                                                                                              \
    int wgid = (tile_);                                                                                             \
    { int q = nwg / NXCD, r = nwg % NXCD, xcd = wgid % NXCD, off = wgid / NXCD; wgid = (xcd < r ? xcd * (q + 1) : r * (q + 1) + (xcd - r) * q) + off; } \
    int nig = WGM * nN, gid = wgid / nig, fm = gid * WGM, gsz = min(nM - fm, WGM);                                  \
    pm_ = fm + ((wgid % nig) % gsz); pn_ = (wgid % nig) / gsz;                                                      \
  } while (0)
#define FIRST_STAGES(pm_, pn_)                                                                                      \
  do {                                                                                                              \
    const u16* A_ = g.A + (g.a_pn_shift >= 0 ? (size_t)((pn_) >> g.a_pn_shift) * K : 0);                            \
    const u16* Bt_ = g.Bt + (g.b_pm_shift >= 0 ? (size_t)((pm_) >> g.b_pm_shift) * ((size_t)g.N * K) : 0);          \
    STAGE(SB(0, 0), Bt_, ldb, (pn_)*BM, 0); STAGE(SA(0, 0), A_, lda, (pm_)*BM, 0);                                  \
    STAGE(SB(0, 1), Bt_, ldb, (pn_)*BM + HALF, 0); STAGE(SA(0, 1), A_, lda, (pm_)*BM + HALF, 0);                    \
  } while (0)
  const int gstep = gdim();
  int tile = bidx(), pm = 0, pn = 0;
  if (tile < nwg) { TILE_COORDS(tile, pm, pn); FIRST_STAGES(pm, pn); }
  while (tile < nwg) {
    const int brow = pm * BM, bcol = pn * BM;
    const u16* __restrict__ A = g.A + (g.a_pn_shift >= 0 ? (size_t)(pn >> g.a_pn_shift) * K : 0);
    const u16* __restrict__ Bt = g.Bt + (g.b_pm_shift >= 0 ? (size_t)(pm >> g.b_pm_shift) * ((size_t)g.N * K) : 0);
    f32x4 acc[2][2][4][2] = {};
    bf16x8 At[4][2], B0[2][2], B1[2][2];
    if (wr == 1) BAR;
    WAIT_V(4); BAR;
    STAGE(SB(1, 0), Bt, ldb, bcol, 1); STAGE(SA(1, 0), A, lda, brow, 1); STAGE(SB(1, 1), Bt, ldb, bcol + HALF, 1);
    WAIT_V(6); BAR;
    for (int t = 0; t < nt - 2; t += 2) {
      LDB(B0, 0, 0); SCHED; LDA(At, 0, 0); STAGE(SA(1, 1), A, lda, brow + HALF, t + 1);
      WAIT_L(8); BAR; WAIT_L(0); MMA(0, 0, At, B0); BAR; SCHED;
      LDB(B1, 0, 1); STAGE(SB(0, 0), Bt, ldb, bcol, t + 2);
      BAR; WAIT_L(0); MMA(0, 1, At, B1); BAR;
      LDA(At, 0, 1); STAGE(SA(0, 0), A, lda, brow, t + 2);
      BAR; WAIT_L(0); MMA(1, 0, At, B0); BAR; SCHED;
      STAGE(SB(0, 1), Bt, ldb, bcol + HALF, t + 2);
      WAIT_V(6); BAR; MMA(1, 1, At, B1); BAR;
      LDB(B0, 1, 0); SCHED; LDA(At, 1, 0); STAGE(SA(0, 1), A, lda, brow + HALF, t + 2);
      WAIT_L(8); BAR; WAIT_L(0); MMA(0, 0, At, B0); BAR; SCHED;
      LDB(B1, 1, 1); STAGE(SB(1, 0), Bt, ldb, bcol, t + 3);
      BAR; WAIT_L(0); MMA(0, 1, At, B1); BAR;
      LDA(At, 1, 1); STAGE(SA(1, 0), A, lda, brow, t + 3);
      BAR; WAIT_L(0); MMA(1, 0, At, B0); BAR; SCHED;
      STAGE(SB(1, 1), Bt, ldb, bcol + HALF, t + 3);
      WAIT_V(6); BAR; MMA(1, 1, At, B1); BAR;
    }
    { LDB(B0, 0, 0); LDA(At, 0, 0); STAGE(SA(1, 1), A, lda, brow + HALF, nt - 1);
      BAR; WAIT_L(0); MMA(0, 0, At, B0); BAR;
      LDB(B1, 0, 1); BAR; WAIT_L(0); MMA(0, 1, At, B1); BAR;
      LDA(At, 0, 1); WAIT_V(4); BAR; WAIT_L(0); MMA(1, 0, At, B0); MMA(1, 1, At, B1); BAR; }
    { LDB(B0, 1, 0); LDA(At, 1, 0); WAIT_V(2); BAR; WAIT_L(0); MMA(0, 0, At, B0); BAR;
      LDB(B1, 1, 1); WAIT_V(0); BAR; WAIT_L(0); MMA(0, 1, At, B1); BAR;
      LDA(At, 1, 1); BAR; WAIT_L(0); MMA(1, 0, At, B0); MMA(1, 1, At, B1); BAR; }
    if (wr == 0) BAR;
    const int ntile = tile + gstep; int npm = 0, npn = 0;
    if (ntile < nwg) { TILE_COORDS(ntile, npm, npn); FIRST_STAGES(npm, npn); }
    {
      int t2 = threadIdx.x;
      asm volatile("" : "+v"(t2));
      const int wid2 = t2 >> 6, lane2 = t2 & 63, wr2 = wid2 >> 2, wc2 = wid2 & 3, fr2 = lane2 & 15, fq2 = lane2 >> 4;
      if constexpr (Epi::REGMODE) {
        epi.reg(acc, shmc + 65536, brow, pn, t2);
      } else {
      float* stg = (float*)(shmc + 65536);
      typename Epi::Pre pre[2];
      epi.pre(pre[0], brow, pn, wid2, lane2);
#pragma unroll
      for (int q = 0; q < 4; ++q) {
        if (q > 0) __syncthreads();
        if (wr2 == (q & 1)) {
#pragma unroll
          for (int m = 0; m < 4; ++m)
#pragma unroll
            for (int bj = 0; bj < 2; ++bj)
#pragma unroll
              for (int n = 0; n < 2; ++n)
                *(f32x4*)(stg + (m * 16 + fr2) * STG_LD + bj * 128 + wc2 * 32 + n * 16 + fq2 * 4) = acc[q >> 1][bj][m][n];
        }
        __syncthreads();
        if (q < 3) epi.pre(pre[(q + 1) & 1], brow + (q + 1) * 64, pn, wid2, lane2);
        epi(pre[q & 1], stg, brow + q * 64, pn, wid2, lane2);
      }
      }
    }
    __syncthreads();
    tile = ntile; pm = npm; pn = npn;
  }
#undef TILE_COORDS
#undef FIRST_STAGES
#undef SA
#undef SB
#undef STAGE
#undef LDA
#undef LDB
#undef MMA
}

typedef f32x4 AccT[2][2][4][2];
DI float row_rstd(const float* ssq, int row) {
  const f32x4 a = *(const f32x4*)(ssq + (size_t)row * 4);
  return rsqrtf(((a[0] + a[1]) + (a[2] + a[3])) * (1.f / 1024.f) + EPS_);
}
struct EpiStore {
  u16* O; int ldc; const float* ssq; int gelu_from;
  static constexpr bool REGMODE = true;
  DI void reg(const AccT& acc, char* lds, int brow, int pn, int t2) const {
    const int wid = t2 >> 6, lane = t2 & 63, wr = wid >> 2, wc = wid & 3, fr = lane & 15, fq = lane >> 4;
    u16* st = (u16*)lds;
    const bool dog = (pn * 256 >= gelu_from);
#pragma unroll
    for (int ai = 0; ai < 2; ++ai) {
      if (ai == 1) __syncthreads();
      f32x4 pq[4];
      if (ssq) {
#pragma unroll
        for (int m = 0; m < 4; ++m) pq[m] = *(const f32x4*)(ssq + (size_t)(brow + ai * 128 + wr * 64 + m * 16 + fr) * 4);
      }
#pragma unroll
      for (int m = 0; m < 4; ++m) {
        const int rl = wr * 64 + m * 16 + fr;
        const float rs = ssq ? rsqrtf(((pq[m][0] + pq[m][1]) + (pq[m][2] + pq[m][3])) * (1.f / 1024.f) + EPS_) : 1.f;
#pragma unroll
        for (int bj = 0; bj < 2; ++bj)
#pragma unroll
          for (int n = 0; n < 2; ++n) {
            f32x4 v = acc[ai][bj][m][n] * rs;
            if (dog) { v[0] = gelu_t(v[0]); v[1] = gelu_t(v[1]); v[2] = gelu_t(v[2]); v[3] = gelu_t(v[3]); }
            uint2 w; w.x = pack2(v[0], v[1]); w.y = pack2(v[2], v[3]);
            *(uint2*)(st + rl * 264 + bj * 128 + wc * 32 + n * 16 + fq * 4) = w;
          }
      }
      __syncthreads();
#pragma unroll
      for (int i = 0; i < 8; ++i) {
        const int c = t2 + 512 * i, row = c >> 5, seg = c & 31;
        const uint4 w = *(const uint4*)(st + row * 264 + seg * 8);
        *(uint4*)(O + (size_t)(brow + ai * 128 + row) * ldc + pn * 256 + seg * 8) = w;
      }
    }
  }
  struct Pre {};
  DI void pre(Pre&, int, int, int, int) const {}
  DI void operator()(const Pre&, const float* stg, int brow, int pn, int wv, int lane) const {
    const bool dog = (pn * 256 >= gelu_from);
#pragma unroll 4
    for (int rr = wv; rr < 64; rr += 8) {
      const int row = brow + rr;
      const float rs = ssq ? row_rstd(ssq, row) : 1.f;
      f32x4 v = *(const f32x4*)(stg + rr * STG_LD + lane * 4) * rs;
      if (dog) { v[0] = gelu_t(v[0]); v[1] = gelu_t(v[1]); v[2] = gelu_t(v[2]); v[3] = gelu_t(v[3]); }
      uint2 w; w.x = pack2(v[0], v[1]); w.y = pack2(v[2], v[3]);
      *(uint2*)(O + (size_t)row * ldc + pn * 256 + lane * 4) = w;
    }
  }
};

struct EpiMobaIn {
  u16* RAW; const float* ssq; const float* kgain; u16* KN; u16* VT; float* KMEAN;
  static constexpr bool REGMODE = true;
  struct Pre {};
  DI void pre(Pre&, int, int, int, int) const {}
  DI void operator()(const Pre&, const float*, int, int, int, int) const {}
  DI void reg(const AccT& acc, char* lds, int brow, int pn, int t2) const {
    const int wid = t2 >> 6, lane = t2 & 63, wr = wid >> 2, wc = wid & 3, fr = lane & 15, fq = lane >> 4;
    u16* st = (u16*)lds;
    float* red = (float*)(lds + 67584);
    const int b = brow >> 12, tloc = brow & (S_ - 1), nblk = tloc >> 8;
    float ksum = 0.f;
#pragma unroll
    for (int ai = 0; ai < 2; ++ai) {
      if (ai == 1) __syncthreads();
      f32x4 pq[4];
#pragma unroll
      for (int m = 0; m < 4; ++m) pq[m] = *(const f32x4*)(ssq + (size_t)(brow + ai * 128 + wr * 64 + m * 16 + fr) * 4);
#pragma unroll
      for (int m = 0; m < 4; ++m) {
        const int rl = wr * 64 + m * 16 + fr;
        const float rs = rsqrtf(((pq[m][0] + pq[m][1]) + (pq[m][2] + pq[m][3])) * (1.f / 1024.f) + EPS_);
#pragma unroll
        for (int bj = 0; bj < 2; ++bj)
#pragma unroll
          for (int n = 0; n < 2; ++n) {
            const f32x4 v = acc[ai][bj][m][n] * rs;
            uint2 w; w.x = pack2(v[0], v[1]); w.y = pack2(v[2], v[3]);
            *(uint2*)(st + rl * 264 + bj * 128 + wc * 32 + n * 16 + fq * 4) = w;
          }
      }
      __syncthreads();
      if (pn < 4) {
#pragma unroll
        for (int i = 0; i < 8; ++i) {
          const int c = t2 + 512 * i, row = c >> 5, seg = c & 31;
          const uint4 w = *(const uint4*)(st + row * 264 + seg * 8);
          *(uint4*)(RAW + (size_t)(brow + ai * 128 + row) * 3072 + pn * 256 + seg * 8) = w;
        }
      } else if (pn < 8) {
        const int seg = t2 & 31, d0 = (seg & 7) * 8;
        float gn[8], cs[8];
#pragma unroll
        for (int j = 0; j < 8; ++j) { gn[j] = kgain[d0 + j]; cs[j] = 0.f; }
#pragma unroll
        for (int i = 0; i < 8; ++i) {
          const int row = (t2 >> 5) + 16 * i;
          const uint4 w = *(const uint4*)(st + row * 264 + seg * 8);
          const unsigned uu[4] = {w.x, w.y, w.z, w.w};
          float v[8]; float ss = 0.f;
#pragma unroll
          for (int q = 0; q < 4; ++q) { v[2 * q] = bf2f((u16)(uu[q] & 0xffff)); v[2 * q + 1] = bf2f((u16)(uu[q] >> 16)); }
#pragma unroll
          for (int j = 0; j < 8; ++j) ss += v[j] * v[j];
          ss += __shfl_xor(ss, 1); ss += __shfl_xor(ss, 2); ss += __shfl_xor(ss, 4);
          const float r2 = rsqrtf(ss * (1.f / 64.f) + EPS_);
#pragma unroll
          for (int j = 0; j < 8; ++j) { v[j] = v[j] * r2 * gn[j]; cs[j] += v[j]; }
          uint4 o4; o4.x = pack2(v[0], v[1]); o4.y = pack2(v[2], v[3]); o4.z = pack2(v[4], v[5]); o4.w = pack2(v[6], v[7]);
          *(uint4*)(KN + (size_t)(brow + ai * 128 + row) * 1024 + (pn - 4) * 256 + seg * 8) = o4;
        }
#pragma unroll
        for (int j = 0; j < 8; ++j) cs[j] += __shfl_xor(cs[j], 32);
        if (lane < 32) {
#pragma unroll
          for (int j = 0; j < 8; ++j) red[wid * 256 + seg * 8 + j] = cs[j];
        }
        __syncthreads();
        if (t2 < 256) { float sm = 0.f;
#pragma unroll
          for (int w8 = 0; w8 < 8; ++w8) sm += red[w8 * 256 + t2];
          ksum += sm; }
      } else {
#pragma unroll
        for (int i = 0; i < 8; ++i) {
          const int item = t2 + 512 * i, rg = item & 15, col = item >> 4;
          unsigned uu[4];
#pragma unroll
          for (int q = 0; q < 4; ++q) uu[q] = (unsigned)st[(rg * 8 + 2 * q) * 264 + col] | ((unsigned)st[(rg * 8 + 2 * q + 1) * 264 + col] << 16);
          uint4 o4; o4.x = uu[0]; o4.y = uu[1]; o4.z = uu[2]; o4.w = uu[3];
          *(uint4*)(VT + (size_t)(b * 1024 + (pn - 8) * 256 + col) * S_ + tloc + ai * 128 + rg * 8) = o4;
        }
      }
    }
    if (pn >= 4 && pn < 8 && t2 < 256) KMEAN[((size_t)(b * 16 + (pn - 4) * 4 + (t2 >> 6)) * 16 + nblk) * 64 + (t2 & 63)] = ksum * (1.f / 256.f);
  }
};

struct EpiSwiglu {
  u16* O; const float* ssq;
  static constexpr bool REGMODE = true;
  DI void reg(const AccT& acc, char* lds, int brow, int pn, int t2) const {
    const int wid = t2 >> 6, lane = t2 & 63, wr = wid >> 2, wc = wid & 3, fr = lane & 15, fq = lane >> 4;
    u16* st = (u16*)lds;
    f32x4 pq[8];
#pragma unroll
    for (int q = 0; q < 8; ++q) pq[q] = *(const f32x4*)(ssq + (size_t)(brow + (q >> 2) * 128 + wr * 64 + (q & 3) * 16 + fr) * 4);
#pragma unroll
    for (int ai = 0; ai < 2; ++ai)
#pragma unroll
      for (int m = 0; m < 4; ++m) {
        const int rl = ai * 128 + wr * 64 + m * 16 + fr;
        const f32x4 q4 = pq[ai * 4 + m];
        const float rs = rsqrtf(((q4[0] + q4[1]) + (q4[2] + q4[3])) * (1.f / 1024.f) + EPS_);
#pragma unroll
        for (int n = 0; n < 2; ++n) {
          const f32x4 gt = acc[ai][0][m][n] * rs, up = acc[ai][1][m][n] * rs;
          f32x4 v;
#pragma unroll
          for (int j = 0; j < 4; ++j) v[j] = gt[j] * sigmoidf(gt[j]) * up[j];
          uint2 w; w.x = pack2(v[0], v[1]); w.y = pack2(v[2], v[3]);
          *(uint2*)(st + rl * 136 + wc * 32 + n * 16 + fq * 4) = w;
        }
      }
    __syncthreads();
#pragma unroll
    for (int i = 0; i < 8; ++i) {
      const int c = t2 + 512 * i, row = c >> 4, seg = c & 15;
      const uint4 w = *(const uint4*)(st + row * 136 + seg * 8);
      *(uint4*)(O + (size_t)(brow + row) * F_ + pn * 128 + seg * 8) = w;
    }
  }
  struct Pre {};
  DI void pre(Pre&, int, int, int, int) const {}
  DI void operator()(const Pre&, const float* stg, int brow, int pn, int wv, int lane) const {
    const int l32 = lane & 31;
#pragma unroll 4
    for (int rp = wv; rp < 32; rp += 8) {
      const int rr = rp * 2 + (lane >> 5), row = brow + rr;
      const float rs = row_rstd(ssq, row);
      const f32x4 gt = *(const f32x4*)(stg + rr * STG_LD + l32 * 4) * rs, up = *(const f32x4*)(stg + rr * STG_LD + 128 + l32 * 4) * rs;
      f32x4 v;
#pragma unroll
      for (int j = 0; j < 4; ++j) v[j] = gt[j] * sigmoidf(gt[j]) * up[j];
      uint2 w; w.x = pack2(v[0], v[1]); w.y = pack2(v[2], v[3]);
      *(uint2*)(O + (size_t)row * F_ + pn * 128 + l32 * 4) = w;
    }
  }
};

struct EpiResid {
  float* fout; u16* hb; float* ssq_next; float scale;
  static constexpr bool REGMODE = true;
  struct Pre {};
  DI void pre(Pre&, int, int, int, int) const {}
  DI void operator()(const Pre&, const float*, int, int, int, int) const {}
  DI void reg(const AccT& acc, char* lds, int brow, int pn, int t2) const {
    const int wid = t2 >> 6, lane = t2 & 63, wr = wid >> 2, wc = wid & 3, fr = lane & 15, fq = lane >> 4;
    u16* st = (u16*)lds;
#pragma unroll
    for (int ai = 0; ai < 2; ++ai) {
      if (ai == 1) __syncthreads();
      uint4 hq[8];
#pragma unroll
      for (int i = 0; i < 8; ++i) { const int c = t2 + 512 * i; hq[i] = *(const uint4*)(hb + (size_t)(brow + ai * 128 + (c >> 5)) * D_ + pn * 256 + (c & 31) * 8); }
#pragma unroll
      for (int m = 0; m < 4; ++m) {
        const int rl = wr * 64 + m * 16 + fr;
#pragma unroll
        for (int bj = 0; bj < 2; ++bj)
#pragma unroll
          for (int n = 0; n < 2; ++n) {
            const f32x4 v = acc[ai][bj][m][n] * scale;
            uint2 w; w.x = pack2(v[0], v[1]); w.y = pack2(v[2], v[3]);
            *(uint2*)(st + rl * 264 + bj * 128 + wc * 32 + n * 16 + fq * 4) = w;
          }
      }
      __syncthreads();
#pragma unroll
      for (int i = 0; i < 8; ++i) {
        const int c = t2 + 512 * i, row = c >> 5, seg = c & 31;
        const uint4 dw = *(const uint4*)(st + row * 264 + seg * 8);
        const unsigned du[4] = {dw.x, dw.y, dw.z, dw.w}, hu[4] = {hq[i].x, hq[i].y, hq[i].z, hq[i].w};
        float hv[8]; float sq = 0.f;
#pragma unroll
        for (int q = 0; q < 4; ++q) {
          hv[2 * q] = bf2f((u16)(hu[q] & 0xffff)) + bf2f((u16)(du[q] & 0xffff));
          hv[2 * q + 1] = bf2f((u16)(hu[q] >> 16)) + bf2f((u16)(du[q] >> 16));
          sq += hv[2 * q] * hv[2 * q] + hv[2 * q + 1] * hv[2 * q + 1];
        }
        const size_t idx = (size_t)(brow + ai * 128 + row) * D_ + pn * 256 + seg * 8;
        if (fout) { *(f32x4*)(fout + idx) = (f32x4){hv[0], hv[1], hv[2], hv[3]}; *(f32x4*)(fout + idx + 4) = (f32x4){hv[4], hv[5], hv[6], hv[7]}; }
        uint4 o4; o4.x = pack2(hv[0], hv[1]); o4.y = pack2(hv[2], hv[3]); o4.z = pack2(hv[4], hv[5]); o4.w = pack2(hv[6], hv[7]);
        if (!fout) *(uint4*)(hb + idx) = o4;
        if (ssq_next) {
          sq += __shfl_xor(sq, 1); sq += __shfl_xor(sq, 2); sq += __shfl_xor(sq, 4); sq += __shfl_xor(sq, 8); sq += __shfl_xor(sq, 16);
          if (seg == 0) ssq_next[(size_t)(brow + ai * 128 + row) * 4 + pn] = sq;
        }
      }
    }
  }
};

struct EpiLruGate {
  static constexpr bool REGMODE = false;
  DI void reg(const AccT&, char*, int, int, int) const {}
  const float* ba; const float* bx; const float* lam; const u16* xc; float* a; float* b;
  struct Pre {};
  DI void pre(Pre&, int, int, int, int) const {}
  DI void operator()(const Pre&, const float* stg, int brow, int pn, int wv, int lane) const {
    const int l32 = lane & 31;
    const int ch = (pn >> 1) * 256 + (pn & 1) * 128 + l32 * 4;
    const f32x4 vba = *(const f32x4*)(ba + ch), vbx = *(const f32x4*)(bx + ch), vl = *(const f32x4*)(lam + ch);
    f32x4 sp;
#pragma unroll
    for (int j = 0; j < 4; ++j) sp[j] = __logf(1.f + __expf(-vl[j]));
#pragma unroll 2
    for (int rp = wv; rp < 32; rp += 8) {
      const int rr = rp * 2 + (lane >> 5), row = brow + rr;
      const size_t idx = (size_t)row * D_ + ch;
      const uint2 xw = *(const uint2*)(xc + idx);
      const float xv[4] = {bf2f((u16)(xw.x & 0xffff)), bf2f((u16)(xw.x >> 16)), bf2f((u16)(xw.y & 0xffff)), bf2f((u16)(xw.y >> 16))};
      const f32x4 ra = *(const f32x4*)(stg + rr * STG_LD + l32 * 4), ia = *(const f32x4*)(stg + rr * STG_LD + 128 + l32 * 4);
      f32x4 av, bv;
#pragma unroll
      for (int j = 0; j < 4; ++j) {
        const float r = sigmoidf(ra[j] + vba[j]), ig = sigmoidf(ia[j] + vbx[j]);
        const float la = -8.f * r * sp[j];
        const float x2 = 2.f * la;
        float mult = sqrtf((x2 > -0.05f) ? -x2 * (1.f + x2 * (0.5f + x2 * (0.16666667f + x2 * 0.041666667f))) : 1.f - __expf(x2));
        if ((row & (S_ - 1)) == 0) mult = 1.f;
        av[j] = __expf(la); bv[j] = mult * ig * xv[j];
      }
      *(f32x4*)(a + idx) = av; *(f32x4*)(b + idx) = bv;
    }
  }
};

constexpr int KLD = 72;
constexpr int VLD = 68;
#define MFMA32(a, b, c) __builtin_amdgcn_mfma_f32_32x32x16_bf16((a), (b), (c), 0, 0, 0)

DI int keyoff(int sb, int i, int hf) { return sb * 32 + (i >> 2) * 8 + hf * 4 + (i & 3); }

DI void qk_scores(const u16* Ks, const bf16x8 (&qf)[4], int lane, f32x16 (&s)[2]) {
  const int r = lane & 31, hf = lane >> 5;
#pragma unroll
  for (int sb = 0; sb < 2; ++sb) {
    f32x16 acc = {};
#pragma unroll
    for (int st = 0; st < 4; ++st) {
      const bf16x8 a = *(const bf16x8*)(Ks + (sb * 32 + r) * KLD + st * 16 + hf * 8);
      acc = MFMA32(a, qf[st], acc);
    }
    s[sb] = acc;
  }
}

DI void pv_acc(const u16* Vs, const f32x16 (&p)[2], f32x16 (&o)[2], int lane, unsigned pmask = 0xffffffffu) {
  const int r = lane & 31, hf = lane >> 5;
#pragma unroll
  for (int sb = 0; sb < 2; ++sb)
#pragma unroll
    for (int c = 0; c < 2; ++c) {
      union { bf16x8 v; unsigned u[4]; } pb;
#pragma unroll
      for (int q = 0; q < 4; ++q) pb.u[q] = pack2(p[sb][8 * c + 2 * q], p[sb][8 * c + 2 * q + 1]) & pmask;
#pragma unroll
      for (int db = 0; db < 2; ++db) {
        const u16* vp = Vs + (db * 32 + r) * VLD + sb * 32 + c * 16 + hf * 4;
        union { bf16x8 v; s16x4 h[2]; } a;
        a.h[0] = *(const s16x4*)(vp); a.h[1] = *(const s16x4*)(vp + 8);
        o[db] = MFMA32(a.v, pb.v, o[db]);
      }
    }
}

template <class VF>
DI void softmax_pv(const u16* Vs, f32x16 (&s)[2], float& m, float& l, f32x16 (&o)[2], int lane, VF validf) {
  const int hf = lane >> 5;
  float ls = 0.f;
#pragma unroll
  for (int sb = 0; sb < 2; ++sb)
#pragma unroll
    for (int i = 0; i < 16; ++i) { const float pv = validf(keyoff(sb, i, hf)) ? __builtin_amdgcn_exp2f(s[sb][i]) : 0.f; s[sb][i] = pv; ls += pv; }
  l += ls;
  pv_acc(Vs, s, o, lane);
}

DI void softmax_pv_lane(const u16* Vs, f32x16 (&s)[2], float& m, float& l, f32x16 (&o)[2], int lane, bool lv) {
  const float me = lv ? 0.f : 1e30f;
  float ls = 0.f;
#pragma unroll
  for (int sb = 0; sb < 2; ++sb)
#pragma unroll
    for (int i = 0; i < 16; ++i) { const float pv = __builtin_amdgcn_exp2f(s[sb][i] - me); s[sb][i] = pv; ls += pv; }
  l += ls;
  pv_acc(Vs, s, o, lane);
}

DI unsigned prob_lane(f32x16 (&s)[2], float& l, bool lv) {
  float ls = 0.f;
#pragma unroll
  for (int sb = 0; sb < 2; ++sb)
#pragma unroll
    for (int i = 0; i < 16; ++i) { const float pv = __builtin_amdgcn_exp2f(s[sb][i]); s[sb][i] = pv; ls += pv; }
  l += lv ? ls : 0.f;
  return lv ? 0xffffffffu : 0u;
}
template <class VF>
DI void prob_elem(f32x16 (&s)[2], float& l, int lane, VF validf) {
  const int hf = lane >> 5;
  float ls = 0.f;
#pragma unroll
  for (int sb = 0; sb < 2; ++sb)
#pragma unroll
    for (int i = 0; i < 16; ++i) { const float pv = validf(keyoff(sb, i, hf)) ? __builtin_amdgcn_exp2f(s[sb][i]) : 0.f; s[sb][i] = pv; ls += pv; }
  l += ls;
}

DI void kv_load(int tid, const u16* kb, int kld, const u16* vb, int vld, int key0, uint4& kr, uint4& vr) {
  const int r = tid >> 3, seg = tid & 7;
  kr = *(const uint4*)(kb + (size_t)(key0 + r) * kld + seg * 8);
  vr = *(const uint4*)(vb + (size_t)r * vld + key0 + seg * 8);
}
DI void kv_store(int tid, u16* Ks, u16* Vs, const uint4& kr, const uint4& vr) {
  const int r = tid >> 3, seg = tid & 7;
  *(uint4*)(Ks + r * KLD + seg * 8) = kr;
  { uint2 lo; lo.x = vr.x; lo.y = vr.y; uint2 hi; hi.x = vr.z; hi.y = vr.w; *(uint2*)(Vs + r * VLD + seg * 8) = lo; *(uint2*)(Vs + r * VLD + seg * 8 + 4) = hi; }
}

template <class TF>
DI void attn_loop(int tid, const int* list, int cnt, const u16* kb, int kld, const u16* vb, int vld, u16* Ks, u16* Vs, TF f) {
  constexpr int BUFO = 2 * 64 * KLD;
  uint4 k0r, v0r, k1r, v1r;
  if (cnt > 0) kv_load(tid, kb, kld, vb, vld, list[0], k0r, v0r);
  if (cnt > 1) kv_load(tid, kb, kld, vb, vld, list[1], k1r, v1r);
  if (cnt > 0) kv_store(tid, Ks, Vs, k0r, v0r);
  __syncthreads();
  for (int it = 0; it < cnt; it += 2) {
    if (it + 2 < cnt) kv_load(tid, kb, kld, vb, vld, list[it + 2], k0r, v0r);
    f(list[it], Ks, Vs);
    if (it + 1 < cnt) kv_store(tid, Ks + BUFO, Vs + BUFO, k1r, v1r);
    __syncthreads();
    if (it + 1 < cnt) {
      if (it + 3 < cnt) kv_load(tid, kb, kld, vb, vld, list[it + 3], k1r, v1r);
      f(list[it + 1], Ks + BUFO, Vs + BUFO);
      if (it + 2 < cnt) kv_store(tid, Ks, Vs, k0r, v0r);
      __syncthreads();
    }
  }
}

template <class TF>
DI void attn_loop_p2(int tid, const int* list, int cnt, const u16* kb, int kld, const u16* vb, int vld, u16* Ks, TF f) {
  constexpr int BUFO = 2 * 64 * KLD;
  if (cnt <= 0) return;
  uint4 k0r, v0r, k1r, v1r;
  kv_load(tid, kb, kld, vb, vld, list[0], k0r, v0r);
  kv_load(tid, kb, kld, vb, vld, list[1], k1r, v1r);
  kv_store(tid, Ks, Ks + 64 * KLD, k0r, v0r);
  kv_store(tid, Ks + BUFO, Ks + BUFO + 64 * KLD, k1r, v1r);
  __syncthreads();
  for (int it = 0; it < cnt; it += 2) {
    const int base = ((it >> 1) & 1) * 2;
    u16* Ka = Ks + base * BUFO; u16* Kb = Ka + BUFO;
    u16* Na = Ks + (2 - base) * BUFO; u16* Nb = Na + BUFO;
    if (it + 2 < cnt) { kv_load(tid, kb, kld, vb, vld, list[it + 2], k0r, v0r); kv_load(tid, kb, kld, vb, vld, list[it + 3], k1r, v1r); }
    f(list[it], Ka, Ka + 64 * KLD);
    f(list[it + 1], Kb, Kb + 64 * KLD);
    if (it + 2 < cnt) { kv_store(tid, Na, Na + 64 * KLD, k0r, v0r); kv_store(tid, Nb, Nb + 64 * KLD, k1r, v1r); }
    __syncthreads();
  }
}

template <bool keep>
DI void load_q(const u16* qrow, const float* gain, float scale, int lane, bf16x8 (&qf)[4], float (&qn)[32]) {
  const int hf = lane >> 5;
  float v[32]; float ss = 0.f;
#pragma unroll
  for (int st = 0; st < 4; ++st) {
    const uint4 w = *(const uint4*)(qrow + st * 16 + hf * 8);
    const unsigned uu[4] = {w.x, w.y, w.z, w.w};
#pragma unroll
    for (int q = 0; q < 4; ++q) { v[st * 8 + 2 * q] = bf2f((u16)(uu[q] & 0xffff)); v[st * 8 + 2 * q + 1] = bf2f((u16)(uu[q] >> 16)); }
  }
#pragma unroll
  for (int i = 0; i < 32; ++i) ss += v[i] * v[i];
  ss += __shfl_xor(ss, 32);
  const float rs = rsqrtf(ss * (1.f / 64.f) + EPS_);
#pragma unroll
  for (int st = 0; st < 4; ++st) {
    union { bf16x8 v8; unsigned u[4]; } pk;
#pragma unroll
    for (int q = 0; q < 4; ++q) {
      const int d0 = st * 16 + hf * 8 + 2 * q;
      const float a = v[st * 8 + 2 * q] * rs * gain[d0], b = v[st * 8 + 2 * q + 1] * rs * gain[d0 + 1];
      if (keep) { qn[st * 8 + 2 * q] = a; qn[st * 8 + 2 * q + 1] = b; }
      pk.u[q] = pack2(a * scale, b * scale);
    }
    qf[st] = pk.v8;
  }
}

DI void acc_out(f32x16 (&tot)[2], const f32x16 (&o)[2], float w) {
#pragma unroll
  for (int db = 0; db < 2; ++db) tot[db] = tot[db] + o[db] * w;
}
DI void store_out(u16* orow, const f32x16 (&tot)[2], int lane) {
  const int hf = lane >> 5;
#pragma unroll
  for (int db = 0; db < 2; ++db)
#pragma unroll
    for (int gq = 0; gq < 4; ++gq) {
      uint2 w; w.x = pack2(tot[db][gq * 4 + 0], tot[db][gq * 4 + 1]); w.y = pack2(tot[db][gq * 4 + 2], tot[db][gq * 4 + 3]);
      *(uint2*)(orow + db * 32 + gq * 8 + hf * 4) = w;
    }
}

DI void moba_prep(const u16* RAW, const float* kgain, u16* KN, u16* VT, float* KMEAN, char* shm) {
  float* tile = (float*)shm;
  float* part = tile + 256 * 65;
  const int tid = tidx();
  for (int item = bidx(); item < 1024; item += gdim()) {
    const int h = item & 15, n = (item >> 4) & 15, b = item >> 8;
    const int t0 = b * S_ + n * 256;
    {
      const int tk = tid >> 1, half = tid & 1;
      const u16* src = RAW + (size_t)(t0 + tk) * 3072 + 1024 + h * 64 + half * 32;
      float v[32]; float ss = 0.f;
#pragma unroll
      for (int q4 = 0; q4 < 4; ++q4) {
        const uint4 w = *(const uint4*)(src + q4 * 8);
        const unsigned uu[4] = {w.x, w.y, w.z, w.w};
#pragma unroll
        for (int q = 0; q < 4; ++q) { v[q4 * 8 + 2 * q] = bf2f((u16)(uu[q] & 0xffff)); v[q4 * 8 + 2 * q + 1] = bf2f((u16)(uu[q] >> 16)); }
      }
#pragma unroll
      for (int i = 0; i < 32; ++i) ss += v[i] * v[i];
      ss += __shfl_xor(ss, 1);
      const float rs = rsqrtf(ss * (1.f / 64.f) + EPS_);
      u16* dst = KN + (size_t)(t0 + tk) * 1024 + h * 64 + half * 32;
#pragma unroll
      for (int q4 = 0; q4 < 4; ++q4) {
        uint4 w; unsigned uu[4];
#pragma unroll
        for (int q = 0; q < 4; ++q) {
          const int d = half * 32 + q4 * 8 + 2 * q;
          const float a = v[q4 * 8 + 2 * q] * rs * kgain[d], bb = v[q4 * 8 + 2 * q + 1] * rs * kgain[d + 1];
          tile[tk * 65 + d] = a; tile[tk * 65 + d + 1] = bb;
          uu[q] = pack2(a, bb);
        }
        w.x = uu[0]; w.y = uu[1]; w.z = uu[2]; w.w = uu[3];
        *(uint4*)(dst + q4 * 8) = w;
      }
    }
    __syncthreads();
    { const int d = tid & 63, pt = tid >> 6; float s = 0.f;
      for (int i = 0; i < 32; ++i) s += tile[(pt * 32 + i) * 65 + d];
      part[pt * 64 + d] = s; }
    __syncthreads();
    if (tid < 64) { float s = 0.f; for (int i = 0; i < 8; ++i) s += part[i * 64 + tid];
      KMEAN[((size_t)(b * 16 + h) * 16 + n) * 64 + tid] = s * (1.f / 256.f); }
    __syncthreads();
    {
      u16* vt = (u16*)shm;
      const int tk = tid >> 1, half = tid & 1;
      const u16* src = RAW + (size_t)(t0 + tk) * 3072 + 2048 + h * 64 + half * 32;
#pragma unroll
      for (int q4 = 0; q4 < 4; ++q4) {
        const uint4 w = *(const uint4*)(src + q4 * 8);
        unsigned* dp = (unsigned*)(vt + tk * 66 + half * 32 + q4 * 8);
        dp[0] = w.x; dp[1] = w.y; dp[2] = w.z; dp[3] = w.w;
      }
      __syncthreads();
      const int d = tid >> 3, ts = (tid & 7) * 32;
      u16* dst = VT + ((size_t)(b * 1024 + h * 64 + d)) * S_ + n * 256 + ts;
#pragma unroll
      for (int q4 = 0; q4 < 4; ++q4) {
        uint4 w; unsigned uu[4];
#pragma unroll
        for (int q = 0; q < 4; ++q) uu[q] = (unsigned)vt[(ts + q4 * 8 + 2 * q) * 66 + d] | ((unsigned)vt[(ts + q4 * 8 + 2 * q + 1) * 66 + d] << 16);
        w.x = uu[0]; w.y = uu[1]; w.z = uu[2]; w.w = uu[3];
        *(uint4*)(dst + q4 * 8) = w;
      }
    }
    __syncthreads();
  }
}

DI void moba_attn(const u16* RAW, const float* qgain, const u16* KN, const u16* VT, const float* KMEAN, u16* O, char* shm) {
  u16* Ks = (u16*)shm; u16* Vs = Ks + 64 * KLD;
  float* km = (float*)(Ks + 8 * 64 * KLD);
  int* list = (int*)(km + 16 * 64);
  int* misc = list + 64;
  const int tid = tidx(), wv = tid >> 6, lane = tid & 63, r = lane & 31, hf = lane >> 5;
  for (int it0 = bidx(); it0 < 1024; it0 += gdim()) {
    const int rnd = it0 >> 8, idx = it0 & 255, grp = idx >> 6, sub = idx & 63;
    const int own = (rnd == 0) ? 15 - grp : (rnd == 1) ? 8 + grp : (rnd == 2) ? 7 - grp : grp;
    const int b = sub >> 4, h = sub & 15;
    const int pos = own * 256 + wv * 32 + r;
    const size_t tok = (size_t)b * S_ + pos;
    for (int i = tid; i < 1024; i += 512) km[i] = KMEAN[(size_t)(b * 16 + h) * 1024 + i];
    if (tid == 0) misc[0] = 0;
    bf16x8 qf[4]; float qn[32];
    load_q<true>(RAW + tok * 3072 + h * 64, qgain, 0.125f * LOG2E, lane, qf, qn);
    __syncthreads();
    float v0 = -3e38f, v1 = -3e38f, v2 = -3e38f; int i0 = -1, i1 = -1, i2 = -1;
    for (int n = 0; n < own; ++n) {
      float gsum = 0.f;
#pragma unroll
      for (int st = 0; st < 4; ++st)
#pragma unroll
        for (int j = 0; j < 8; ++j) gsum += qn[st * 8 + j] * km[n * 64 + st * 16 + hf * 8 + j];
      gsum += __shfl_xor(gsum, 32);
      if (gsum > v0) { v2 = v1; i2 = i1; v1 = v0; i1 = i0; v0 = gsum; i0 = n; }
      else if (gsum > v1) { v2 = v1; i2 = i1; v1 = gsum; i1 = n; }
      else if (gsum > v2) { v2 = gsum; i2 = n; }
    }
    unsigned mymask = 0;
    if (i0 >= 0) mymask |= 1u << i0;
    if (i1 >= 0) mymask |= 1u << i1;
    if (i2 >= 0) mymask |= 1u << i2;
    unsigned wor = mymask;
#pragma unroll
    for (int o = 1; o < 64; o <<= 1) wor |= (unsigned)__shfl_xor((int)wor, o);
    if (lane == 0) atomicOr((unsigned*)&misc[0], wor);
    __syncthreads();
    if (tid == 0) {
      const unsigned un = (unsigned)misc[0]; int c = 0;
      for (int n = 0; n <= own; ++n) if (n == own || ((un >> n) & 1)) for (int kt = 0; kt < 4; ++kt) list[c++] = n * 256 + kt * 64;
      misc[1] = c;
    }
    __syncthreads();
    const int cnt = misc[1];
    f32x16 o[2] = {}; float m = -1e30f, l = 0.f;
    const int wmax = own * 256 + wv * 32 + 31;
    attn_loop_p2(tid, list, cnt, KN + (size_t)b * S_ * 1024 + h * 64, 1024, VT + (size_t)(b * 1024 + h * 64) * S_, S_, Ks, [&](int key0, const u16* Ks, const u16* Vs) {
      const int n = key0 >> 8;
      const bool need = (n == own) ? (key0 <= wmax) : ((wor >> n) & 1);
      if (need) {
        f32x16 s[2];
        qk_scores(Ks, qf, lane, s);
        unsigned pm = 0xffffffffu;
        if (n != own) pm = prob_lane(s, l, (mymask >> n) & 1);
        else if (key0 + 63 <= wmax - 31) pm = prob_lane(s, l, true);
        else prob_elem(s, l, lane, [&](int ko) { return key0 + ko <= pos; });
        pv_acc(Vs, s, o, lane, pm);
      }
    });
    l += __shfl_xor(l, 32);
    f32x16 tot[2] = {};
    acc_out(tot, o, 1.f / l);
    store_out(O + tok * 1024 + h * 64, tot, lane);
  }
}

DI void lru_conv(const u16* RAW, const float* cw, const float* cb, u16* XC) {
  const int nth = gdim() * 512;
  for (int i = bidx() * 512 + tidx(); i < T_ * 128; i += nth) {
    const int t = i >> 7, c0 = (i & 127) * 8, ts = t & (S_ - 1);
    float acc[8];
#pragma unroll
    for (int j = 0; j < 8; ++j) acc[j] = cb[c0 + j];
#pragma unroll
    for (int k = 0; k < 4; ++k) {
      if (ts - 3 + k >= 0) {
        const uint4 w = *(const uint4*)(RAW + (size_t)(t - 3 + k) * 2048 + c0);
        const unsigned uu[4] = {w.x, w.y, w.z, w.w};
#pragma unroll
        for (int q = 0; q < 4; ++q) {
          acc[2 * q] += cw[k * 1024 + c0 + 2 * q] * bf2f((u16)(uu[q] & 0xffff));
          acc[2 * q + 1] += cw[k * 1024 + c0 + 2 * q + 1] * bf2f((u16)(uu[q] >> 16));
        }
      }
    }
    uint4 w; w.x = pack2(acc[0], acc[1]); w.y = pack2(acc[2], acc[3]); w.z = pack2(acc[4], acc[5]); w.w = pack2(acc[6], acc[7]);
    *(uint4*)(XC + (size_t)t * 1024 + c0) = w;
  }
}

DI void lru_scan1(const float* A, const float* Bv, float* PC, float* HC) {
  const int tid = tidx();
  for (int vb = bidx(); vb < 256; vb += gdim()) {
    const int gi = vb * 512 + tid, cg = gi & 255, c = (gi >> 8) & 127, b = gi >> 15;
    const size_t base = ((size_t)b * S_ + c * 32) * 1024 + cg * 4;
    f32x4 hl = {0.f, 0.f, 0.f, 0.f}, P = {1.f, 1.f, 1.f, 1.f};
#pragma unroll 8
    for (int i = 0; i < 32; ++i) { const f32x4 a = *(const f32x4*)(A + base + (size_t)i * 1024), bb = *(const f32x4*)(Bv + base + (size_t)i * 1024); hl = a * hl + bb; P = P * a; }
    const size_t q = ((size_t)(b * 128 + c)) * 1024 + cg * 4;
    *(f32x4*)(PC + q) = P; *(f32x4*)(HC + q) = hl;
  }
}
DI void lru_scan2(const float* A, const float* Bv, const float* PC, const float* HC, const u16* RAW, u16* HY) {
  const int tid = tidx();
  for (int vb = bidx(); vb < 256; vb += gdim()) {
    const int gi = vb * 512 + tid, cg = gi & 255, c = (gi >> 8) & 127, b = gi >> 15;
    f32x4 h = {0.f, 0.f, 0.f, 0.f};
    {
      int cc = 0;
      for (; cc + 8 <= c; cc += 8) {
        f32x4 Pv[8], Hv[8];
#pragma unroll
        for (int u = 0; u < 8; ++u) { const size_t q = ((size_t)(b * 128 + cc + u)) * 1024 + cg * 4; Pv[u] = *(const f32x4*)(PC + q); Hv[u] = *(const f32x4*)(HC + q); }
#pragma unroll
        for (int u = 0; u < 8; ++u) h = Pv[u] * h + Hv[u];
      }
      for (; cc < c; ++cc) { const size_t q = ((size_t)(b * 128 + cc)) * 1024 + cg * 4; h = *(const f32x4*)(PC + q) * h + *(const f32x4*)(HC + q); }
    }
    const size_t t0 = (size_t)b * S_ + c * 32;
#pragma unroll 8
    for (int i = 0; i < 32; ++i) {
      const size_t t = t0 + i;
      h = *(const f32x4*)(A + t * 1024 + cg * 4) * h + *(const f32x4*)(Bv + t * 1024 + cg * 4);
      const uint2 yw = *(const uint2*)(RAW + t * 2048 + 1024 + cg * 4);
      uint2 w;
      w.x = pack2(h[0] * bf2f((u16)(yw.x & 0xffff)), h[1] * bf2f((u16)(yw.x >> 16)));
      w.y = pack2(h[2] * bf2f((u16)(yw.y & 0xffff)), h[3] * bf2f((u16)(yw.y >> 16)));
      *(uint2*)(HY + t * 1024 + cg * 4) = w;
    }
  }
}

DI void nsa_prep(const u16* RAW, const Params& p, char* scr, char* shm, int mode, int vbid, int vnb) {
  const int tid = tidx();
  const float* gate_b = p.in[20]; const float* ksg = p.in[23]; const float* kwg = p.in[24];
  const float* pos_k = p.in[25]; const float* pos_v = p.in[26];
  u16* KSN = (u16*)(scr + N_KSN); u16* KWN = (u16*)(scr + N_KWN); u16* VST = (u16*)(scr + N_VST); u16* VWT = (u16*)(scr + N_VWT);
  u16* AK = (u16*)(scr + N_AK); u16* AV = (u16*)(scr + N_AV); float* GATES = (float*)(scr + N_GATES);
  if (mode == 2)
  for (int item = vbid; item < 512; item += vnb) {
    const int which = item & 1, g = (item >> 1) & 3, n = (item >> 3) & 15, b = item >> 7;
    const int t0 = b * S_ + n * 256;
    const int kcol = (which ? 2048 : 1536) + g * 64, vcol = (which ? 2304 : 1792) + g * 64;
    const float* gain = which ? kwg : ksg;
    u16* KNo = which ? KWN : KSN; u16* VTo = which ? VWT : VST;
    {
      const int tk = tid >> 1, half = tid & 1;
      const u16* src = RAW + (size_t)(t0 + tk) * 2816 + kcol + half * 32;
      float v[32]; float ss = 0.f;
#pragma unroll
      for (int q4 = 0; q4 < 4; ++q4) {
        const uint4 w = *(const uint4*)(src + q4 * 8);
        const unsigned uu[4] = {w.x, w.y, w.z, w.w};
#pragma unroll
        for (int q = 0; q < 4; ++q) { v[q4 * 8 + 2 * q] = bf2f((u16)(uu[q] & 0xffff)); v[q4 * 8 + 2 * q + 1] = bf2f((u16)(uu[q] >> 16)); }
      }
#pragma unroll
      for (int i = 0; i < 32; ++i) ss += v[i] * v[i];
      ss += __shfl_xor(ss, 1);
      const float rs = rsqrtf(ss * (1.f / 64.f) + EPS_);
      u16* dst = KNo + (size_t)(t0 + tk) * 256 + g * 64 + half * 32;
#pragma unroll
      for (int q4 = 0; q4 < 4; ++q4) {
        unsigned uu[4];
#pragma unroll
        for (int q = 0; q < 4; ++q) { const int d = half * 32 + q4 * 8 + 2 * q; uu[q] = pack2(v[q4 * 8 + 2 * q] * rs * gain[d], v[q4 * 8 + 2 * q + 1] * rs * gain[d + 1]); }
        uint4 w; w.x = uu[0]; w.y = uu[1]; w.z = uu[2]; w.w = uu[3];
        *(uint4*)(dst + q4 * 8) = w;
      }
    }
    {
      u16* vt = (u16*)shm;
      const int tk = tid >> 1, half = tid & 1;
      const u16* src = RAW + (size_t)(t0 + tk) * 2816 + vcol + half * 32;
#pragma unroll
      for (int q4 = 0; q4 < 4; ++q4) {
        const uint4 w = *(const uint4*)(src + q4 * 8);
        unsigned* dp = (unsigned*)(vt + tk * 66 + half * 32 + q4 * 8);
        dp[0] = w.x; dp[1] = w.y; dp[2] = w.z; dp[3] = w.w;
      }
      __syncthreads();
      const int d = tid >> 3, ts = (tid & 7) * 32;
      u16* dst = VTo + ((size_t)(b * 256 + g * 64 + d)) * S_ + n * 256 + ts;
#pragma unroll
      for (int q4 = 0; q4 < 4; ++q4) {
        unsigned uu[4];
#pragma unroll
        for (int q = 0; q < 4; ++q) uu[q] = (unsigned)vt[(ts + q4 * 8 + 2 * q) * 66 + d] | ((unsigned)vt[(ts + q4 * 8 + 2 * q + 1) * 66 + d] << 16);
        uint4 w; w.x = uu[0]; w.y = uu[1]; w.z = uu[2]; w.w = uu[3];
        *(uint4*)(dst + q4 * 8) = w;
      }
      __syncthreads();
    }
  }
  const int nth = vnb * 512, gt = vbid * 512 + tid;
  if (mode == 2)
  for (int i = gt; i < T_ * 48; i += nth) {
    const int t = i / 48, c = i - t * 48;
    GATES[i] = sigmoidf(bf2f(RAW[(size_t)t * 2816 + 2560 + c]) + gate_b[c]);
  }
  if (mode == 1)
  for (int i = gt; i < 4096 * 256; i += nth) {
    const int row = i >> 8, c8 = (i & 255) * 8, ii = c8 >> 6, d = c8 & 63;
    const int n = row & 255, g = (row >> 8) & 3, b = row >> 10;
    uint4 wk = make_uint4(0, 0, 0, 0), wv = wk;
    if (n < 255) {
      const size_t t = (size_t)b * S_ + n * 16 + ii;
      const uint4 rk = *(const uint4*)(RAW + t * 2816 + 1024 + g * 64 + d);
      const uint4 rv = *(const uint4*)(RAW + t * 2816 + 1280 + g * 64 + d);
      const unsigned ku[4] = {rk.x, rk.y, rk.z, rk.w}, vu[4] = {rv.x, rv.y, rv.z, rv.w};
      unsigned ko[4], vo[4];
#pragma unroll
      for (int q = 0; q < 4; ++q) {
        const int e = ii * 64 + d + 2 * q;
        ko[q] = pack2(bf2f((u16)(ku[q] & 0xffff)) + pos_k[e], bf2f((u16)(ku[q] >> 16)) + pos_k[e + 1]);
        vo[q] = pack2(bf2f((u16)(vu[q] & 0xffff)) + pos_v[e], bf2f((u16)(vu[q] >> 16)) + pos_v[e + 1]);
      }
      wk = make_uint4(ko[0], ko[1], ko[2], ko[3]); wv = make_uint4(vo[0], vo[1], vo[2], vo[3]);
    }
    *(uint4*)(AK + (size_t)row * 2048 + c8) = wk;
    *(uint4*)(AV + (size_t)row * 2048 + c8) = wv;
  }
}

DI void nsa_cmp2(const u16* HK, const u16* HV, const float* w2k, const float* w2v, const float* kcg, u16* KCMP, u16* VCMPT) {
  const int tid = tidx(); const int wv = tid >> 6, lane = tid & 63;
  for (int rw = bidx() * 8 + wv; rw < 8192; rw += gdim() * 8) {
    const int which = rw >> 12, row = rw & 4095;
    const u16* hrow = (which ? HV : HK) + (size_t)row * 256;
    const float* w2 = which ? w2v : w2k;
    float acc = 0.f;
#pragma unroll 4
    for (int k0 = 0; k0 < 256; k0 += 8) {
      const uint4 hw = *(const uint4*)(hrow + k0);
      const unsigned uu[4] = {hw.x, hw.y, hw.z, hw.w};
#pragma unroll
      for (int u = 0; u < 4; ++u) {
        acc += bf2f((u16)(uu[u] & 0xffff)) * w2[(k0 + 2 * u) * 64 + lane];
        acc += bf2f((u16)(uu[u] >> 16)) * w2[(k0 + 2 * u + 1) * 64 + lane];
      }
    }
    if (which == 0) {
      float ss = acc * acc;
#pragma unroll
      for (int o = 1; o < 64; o <<= 1) ss += __shfl_xor(ss, o);
      const float rs = rsqrtf(ss * (1.f / 64.f) + EPS_);
      KCMP[(size_t)row * 64 + lane] = f2bf(acc * rs * kcg[lane]);
    } else {
      const int bg = row >> 8, n = row & 255;
      VCMPT[((size_t)bg * 64 + lane) * 256 + n] = f2bf(acc);
    }
  }
}

DI void nsa_attn(const u16* RAW, const Params& p, char* scr, char* shm) {
  const u16* KSN = (const u16*)(scr + N_KSN); const u16* KWN = (const u16*)(scr + N_KWN);
  const u16* VST = (const u16*)(scr + N_VST); const u16* VWT = (const u16*)(scr + N_VWT);
  const u16* KCMP = (const u16*)(scr + N_KCMP); const u16* VCMPT = (const u16*)(scr + N_VCMPT);
  const float* GATES = (const float*)(scr + N_GATES); u16* O = (u16*)(scr + N_O);
  const float* qgain = p.in[21];
  u16* Ks = (u16*)shm; u16* Vs = Ks + 64 * KLD;
  int* list = (int*)(Ks + 4 * 64 * KLD);
  unsigned* selm = (unsigned*)(list + 64);
  unsigned* misc = selm + 128;
  float* invs = (float*)(misc + 4);
  float* totl = invs + 256;
  float* impH = totl;
  const int tid = tidx(), wv = tid >> 6, lane = tid & 63, r = lane & 31, hf = lane >> 5;
  const int hh = wv & 3, qh = wv >> 2;
  for (int it0 = bidx(); it0 < 1024; it0 += gdim()) {
    const int rnd = it0 >> 8, idx = it0 & 255, sub = idx & 15, ci = idx >> 4;
    const int c = (rnd == 0) ? 63 - ci : (rnd == 1) ? 32 + ci : (rnd == 2) ? 31 - ci : ci;
    const int b = sub >> 2, g = sub & 3, h = g * 4 + hh;
    const int ql = qh * 32 + r;
    const int pos = c * 64 + ql;
    const size_t tok = (size_t)b * S_ + pos;
    bf16x8 qf[4]; float qn[32];
    load_q<false>(RAW + tok * 2816 + h * 64, qgain, 0.125f * LOG2E, lane, qf, qn);
    for (int i = tid; i < 4 * 64 * 65; i += 512) impH[i] = 0.f;
    const int ncmp = min(255, 4 * c + 3);
    const int ntile = (ncmp + 63) >> 6;
    if (tid < 64) list[tid] = tid * 64;
    __syncthreads();
    const u16* kcb = KCMP + (size_t)(b * 4 + g) * 256 * 64;
    const u16* vcb = VCMPT + (size_t)(b * 4 + g) * 64 * 256;
    float l = 0.f;
    f32x16 oc[2] = {};
    {
      float* myimp = impH + (hh * 64 + ql) * 65;
      attn_loop(tid, list, ntile, kcb, 64, vcb, 256, Ks, Vs, [&](int key0, const u16* Ks, const u16* Vs) {
        f32x16 s[2];
        qk_scores(Ks, qf, lane, s);
        float ls = 0.f;
#pragma unroll
        for (int sb = 0; sb < 2; ++sb)
#pragma unroll
          for (int i = 0; i < 16; ++i) { const int n = key0 + keyoff(sb, i, hf); const bool v = (n < 255) && (16 * n + 31 <= pos); const float pv = v ? __builtin_amdgcn_exp2f(s[sb][i]) : 0.f; s[sb][i] = pv; ls += pv; }
        l += ls;
        pv_acc(Vs, s, oc, lane);
#pragma unroll
        for (int sb = 0; sb < 2; ++sb)
#pragma unroll
          for (int gi = 0; gi < 4; ++gi) {
            const int j = (key0 >> 2) + sb * 8 + gi * 2 + hf;
            myimp[j] += s[sb][gi * 4] + s[sb][gi * 4 + 1] + s[sb][gi * 4 + 2] + s[sb][gi * 4 + 3];
          }
#pragma unroll
        for (int sb = 0; sb < 2; ++sb)
#pragma unroll
          for (int gi = 0; gi < 4; ++gi) {
            const int j = (key0 >> 2) + sb * 8 + gi * 2 + hf + 1;
            if (j < 64) myimp[j] += s[sb][gi * 4 + 3];
          }
      });
    }
    l += __shfl_xor(l, 32);
    const float invc = (l > 0.f) ? 1.f / l : 0.f;
    if (hf == 0) invs[hh * 64 + ql] = invc;
    __syncthreads();
    {
      unsigned un0 = 0, un1 = 0;
      for (int qq = 0; qq < 8; ++qq) {
        const int q = wv * 8 + qq;
        const int j = lane;
        float v = ((impH[(0 * 64 + q) * 65 + j] * invs[q] + impH[(1 * 64 + q) * 65 + j] * invs[64 + q]) + (impH[(2 * 64 + q) * 65 + j] * invs[128 + q] + impH[(3 * 64 + q) * 65 + j] * invs[192 + q]));
        const bool valid = j <= c;
        const bool forced = (j == 0) || (j == c) || (j == c - 1);
        v = valid ? (forced ? 1e30f : v) : -1e30f;
        int rank = 0;
#pragma unroll
        for (int k = 0; k < 64; ++k) {
          const float vk = __builtin_bit_cast(float, __builtin_amdgcn_readlane(__builtin_bit_cast(int, v), k));
          rank += (vk > v || (vk == v && k < j)) ? 1 : 0;
        }
        const unsigned long long bm = __ballot((rank < 16) && valid);
        if (lane == 0) { selm[q * 2] = (unsigned)bm; selm[q * 2 + 1] = (unsigned)(bm >> 32); }
        un0 |= (unsigned)bm; un1 |= (unsigned)(bm >> 32);
      }
      if (tid == 0) { misc[0] = 0; misc[1] = 0; }
      __syncthreads();
      if (lane == 0) { atomicOr(&misc[0], un0); atomicOr(&misc[1], un1); }
      __syncthreads();
      if (tid == 0) {
        const unsigned long long un = (unsigned long long)misc[0] | ((unsigned long long)misc[1] << 32);
        int cn = 0;
        for (int j = 0; j <= c; ++j) if ((un >> j) & 1) list[cn++] = j * 64;
        misc[2] = cn;
      }
      __syncthreads();
    }
    {
      const float gcv = GATES[tok * 48 + h * 3 + 0] * invc;
#pragma unroll
      for (int db = 0; db < 2; ++db)
#pragma unroll
        for (int i = 0; i < 16; ++i) totl[(db * 16 + i) * 512 + tid] = oc[db][i] * gcv;
    }
    {
      const unsigned long long mym = (unsigned long long)selm[ql * 2] | ((unsigned long long)selm[ql * 2 + 1] << 32);
      unsigned long long wm = mym;
      { unsigned lo = (unsigned)wm, hi = (unsigned)(wm >> 32);
#pragma unroll
        for (int o = 1; o < 32; o <<= 1) { lo |= (unsigned)__shfl_xor((int)lo, o); hi |= (unsigned)__shfl_xor((int)hi, o); }
        wm = (unsigned long long)lo | ((unsigned long long)hi << 32); }
      const int cnt = (int)misc[2];
      f32x16 o[2] = {}; float ms = -1e30f, lsum = 0.f;
      attn_loop(tid, list, cnt, KSN + (size_t)b * S_ * 256 + g * 64, 256, VST + (size_t)(b * 256 + g * 64) * S_, S_, Ks, Vs, [&](int key0, const u16* Ks, const u16* Vs) {
        const int j = key0 >> 6;
        if ((wm >> j) & 1) {
          f32x16 s[2];
          qk_scores(Ks, qf, lane, s);
          unsigned pm = 0xffffffffu;
          if (j != c) pm = prob_lane(s, lsum, (mym >> j) & 1);
          else prob_elem(s, lsum, lane, [&](int ko) { return key0 + ko <= pos; });
          pv_acc(Vs, s, o, lane, pm);
        }
      });
      lsum += __shfl_xor(lsum, 32);
      { const float w = GATES[tok * 48 + h * 3 + 1] / lsum;
#pragma unroll
      for (int db = 0; db < 2; ++db)
#pragma unroll
        for (int i = 0; i < 16; ++i) totl[(db * 16 + i) * 512 + tid] += o[db][i] * w; }
    }
    {
      const int j0 = max(0, c - 8);
      if (tid < 16) list[tid] = (j0 + tid) * 64;
      __syncthreads();
      f32x16 o[2] = {}; float mw = -1e30f, lsum = 0.f;
      attn_loop(tid, list, c - j0 + 1, KWN + (size_t)b * S_ * 256 + g * 64, 256, VWT + (size_t)(b * 256 + g * 64) * S_, S_, Ks, Vs, [&](int key0, const u16* Ks, const u16* Vs) {
        f32x16 s[2];
        qk_scores(Ks, qf, lane, s);
        const int jt = key0 >> 6;
        if (jt > c - 8 && jt < c) (void)prob_lane(s, lsum, true);
        else prob_elem(s, lsum, lane, [&](int ko) { const int kp = key0 + ko; return (kp <= pos) && (kp > pos - 512); });
        pv_acc(Vs, s, o, lane);
      });
      lsum += __shfl_xor(lsum, 32);
      { const float w = GATES[tok * 48 + h * 3 + 2] / lsum;
#pragma unroll
      for (int db = 0; db < 2; ++db)
#pragma unroll
        for (int i = 0; i < 16; ++i) o[db][i] = totl[(db * 16 + i) * 512 + tid] + o[db][i] * w; }
      store_out(O + tok * 1024 + h * 64, o, lane);
    }
    __syncthreads();
  }
}

DI void op_init(const Params& p, char* shm) {
  const float* x = p.in[0];
  u16* HB = (u16*)(p.ws + OFF_HB); float* SSQ = (float*)(p.ws + OFF_SSQ);
  const int tid = tidx(); const int wv = tid >> 6, lane = tid & 63;
  for (int row = bidx() * 8 + wv; row < T_; row += gdim() * 8) {
    float ss = 0.f;
#pragma unroll
    for (int i = 0; i < 4; ++i) {
      const int col = (i * 64 + lane) * 4;
      const float4 v = *(const float4*)(x + (size_t)row * D_ + col);
      ss += v.x * v.x + v.y * v.y + v.z * v.z + v.w * v.w;
      uint2 w; w.x = pack2(v.x, v.y); w.y = pack2(v.z, v.w);
      *(uint2*)(HB + (size_t)row * D_ + col) = w;
    }
#pragma unroll
    for (int o = 1; o < 64; o <<= 1) ss += __shfl_xor(ss, o);
    if (lane < 4) SSQ[(size_t)row * 4 + lane] = (lane == 0) ? ss : 0.f;
  }
  convert_layer(p, 0, shm, (int)blockIdx.x, (int)gridDim.x, 1);
}

template <int OPC, int KINDC>
DI void run_op(const Params& p, int L, int op_rt, char* shm) {
  const int op = (OPC >= 0) ? OPC : op_rt;
  const int kind = (KINDC >= 0) ? KINDC : L % 3, j = L / 3;
  char* ws = p.ws;
  asm volatile("" : "+s"(ws));
  char* scr = ws + OFF_SCR;
  u16* WT = (u16*)(ws + (size_t)(L & 1) * WT_BYTES);
  u16* HB = (u16*)(ws + OFF_HB); float* SSQ = (float*)(ws + OFF_SSQ);
  u16* HID = (u16*)scr;
  switch (op) {
    case OP_INIT: op_init(p, shm); break;
    case OP_UP1: case OP_UP2: {
      const int w = (op == OP_UP1) ? 0 : 2;
      GemmArgs g{HB, D_, WT + (w ? W_UP2 : W_UP1), D_, T_, 2 * F_, D_, -1, -1};
      gemm_phase(g, EpiSwiglu{HID, SSQ + (size_t)w * SSQ_STRIDE}, shm);
      if (op == OP_UP1) { if (L == 0) convert_on_idle(p, 0, shm, (T_ / 256) * (2 * F_ / 256), 2); }
      else convert_on_idle(p, L + 1, shm, (T_ / 256) * (2 * F_ / 256), 3);
    } break;
    case OP_DN1: case OP_DN2: {
      const bool first = (op == OP_DN1);
      GemmArgs g{HID, F_, WT + (first ? W_DN1 : W_DN2), F_, T_, D_, F_, -1, -1};
      float* nx = first ? SSQ + SSQ_STRIDE : (L < 3 ? SSQ : nullptr);
      if (PROBE_DUP & 64) { gemm_phase(g, EpiStore{(u16*)(scr + 100 * MB), D_, nullptr, 1 << 30}, shm); __syncthreads(); }
      gemm_phase(g, EpiResid{(!first && L == 3) ? p.out : nullptr, HB, nx, 0.5f}, shm);
    } break;
    case OP_IN: {
      const int N = (kind == 0) ? 3072 : (kind == 1) ? 2048 : 2816;
      GemmArgs g{HB, D_, WT + W_MIN, D_, T_, N, D_, -1, -1};
      if (kind == 0) gemm_phase(g, EpiMobaIn{(u16*)scr, SSQ + SSQ_STRIDE, p.in[8] + j * 64, (u16*)(scr + A_KN), (u16*)(scr + A_VT), (float*)(scr + A_KMEAN)}, shm);
      else gemm_phase(g, EpiStore{(u16*)scr, N, SSQ + SSQ_STRIDE, (kind == 1) ? 1024 : (1 << 30)}, shm);
    } break;
    case OP_OUT: {
      const u16* Oa = (const u16*)(scr + L_HY);
      GemmArgs g{Oa, D_, WT + W_MOUT, D_, T_, D_, D_, -1, -1};
      if (PROBE_DUP & 64) { gemm_phase(g, EpiStore{(u16*)(scr + 100 * MB), D_, nullptr, 1 << 30}, shm); __syncthreads(); }
      gemm_phase(g, EpiResid{nullptr, HB, SSQ + 2 * SSQ_STRIDE, 1.0f}, shm);
    } break;
    case OP_M1:
      if (kind == 0) moba_prep((const u16*)scr, p.in[8] + j * 64, (u16*)(scr + A_KN), (u16*)(scr + A_VT), (float*)(scr + A_KMEAN), shm);
      else if (kind == 1) lru_conv((const u16*)scr, p.in[11], p.in[12], (u16*)(scr + L_XC));
      else nsa_prep((const u16*)scr, p, scr, shm, 1, (int)blockIdx.x, (int)gridDim.x);
      break;
    case OP_M2:
      if (kind == 0) moba_attn((const u16*)scr, p.in[7] + j * 64, (const u16*)(scr + A_KN), (const u16*)(scr + A_VT), (const float*)(scr + A_KMEAN), (u16*)(scr + A_O), shm);
      else if (kind == 1) {
        GemmArgs g{(const u16*)(scr + L_XC), D_, WT + W_EXT, 256, T_, 2048, 256, 1, -1};
        gemm_phase(g, EpiLruGate{p.in[14], p.in[16], p.in[17], (const u16*)(scr + L_XC), (float*)(scr + L_A), (float*)(scr + L_B)}, shm);
      } else {
        GemmArgs g1{(const u16*)(scr + N_AK), 2048, WT + W_EXT, 2048, 8192, 256, 2048, -1, 4};
        gemm_phase(g1, EpiStore{(u16*)(scr + N_HK), 256, nullptr, 0}, shm);
        { const int nb = (int)gridDim.x, bid = (int)blockIdx.x;
          if (nb > 32) { if (bid >= 32) nsa_prep((const u16*)scr, p, scr, shm, 2, bid - 32, nb - 32); }
          else nsa_prep((const u16*)scr, p, scr, shm, 2, bid, nb); }
      }
      break;
    case OP_M3:
      if (kind == 1) lru_scan1((const float*)(scr + L_A), (const float*)(scr + L_B), (float*)(ws + OFF_PC), (float*)(ws + OFF_HC));
      else if (kind == 2) nsa_cmp2((const u16*)(scr + N_HK), (const u16*)(scr + N_HV), p.in[28], p.in[30], p.in[22], (u16*)(scr + N_KCMP), (u16*)(scr + N_VCMPT));
      break;
    case OP_M4:
      if (kind == 1) lru_scan2((const float*)(scr + L_A), (const float*)(scr + L_B), (const float*)(ws + OFF_PC), (const float*)(ws + OFF_HC), (const u16*)scr, (u16*)(scr + L_HY));
      else if (kind == 2) nsa_attn((const u16*)scr, p, scr, shm);
      break;
  }
}

#if MEGA
constexpr size_t OFF_BAR = 133 * MB;
constexpr int LDS_ST = 143360 - 32;
DI unsigned ld_agent(const unsigned* p) { return __hip_atomic_load(p, __ATOMIC_RELAXED, __HIP_MEMORY_SCOPE_AGENT); }
DI unsigned add_agent(unsigned* p) { return __hip_atomic_fetch_add(p, 1u, __ATOMIC_RELAXED, __HIP_MEMORY_SCOPE_AGENT); }
DI unsigned xcc_id() { return (unsigned)__builtin_amdgcn_s_getreg((3 << 11) | 20) & 0xFu; }
DI void bar_post(unsigned* bar) { if (tidx() == 0) (void)add_agent(&bar[1024 + 32 * xcc_id()]); }
DI void bar_setup(unsigned* bar, char* shm) {
  if (tidx() == 0) {
    const unsigned x = xcc_id(); unsigned nloc = 1, nx = 0;
    for (unsigned j = 0; j < 16; ++j) { const unsigned c = ld_agent(&bar[1024 + 32 * j]); nx += (c > 0u) ? 1u : 0u; if (j == x) nloc = c; }
    volatile unsigned* st = (volatile unsigned*)(shm + LDS_ST);
    st[0] = nloc; st[1] = nx; st[2] = x;
  }
  __syncthreads();
}
DI void grid_bar(unsigned* bar, char* shm) {
  asm volatile("s_waitcnt vmcnt(0)" ::: "memory");
  __syncthreads();
  if (tidx() == 0) {
    volatile unsigned* st = (volatile unsigned*)(shm + LDS_ST);
    const unsigned nloc = st[0], nx = st[1], x = st[2];
    const unsigned old = add_agent(&bar[32 * x]);
    const unsigned gen = old / nloc;
    if (old + 1u == (gen + 1u) * nloc) {
      __builtin_amdgcn_fence(__ATOMIC_RELEASE, "agent");
      asm volatile("s_waitcnt vmcnt(0)" ::: "memory");
      const unsigned og = add_agent(&bar[1536]);
      const unsigned tg = og / nx;
      if (og + 1u == (tg + 1u) * nx) (void)add_agent(&bar[1568]);
      else while (ld_agent(&bar[1568]) == tg) __builtin_amdgcn_s_sleep(1);
      __builtin_amdgcn_fence(__ATOMIC_ACQUIRE, "agent");
      (void)add_agent(&bar[512 + 32 * x]);
      asm volatile("s_waitcnt vmcnt(0)" ::: "memory");
    } else {
      while (ld_agent(&bar[512 + 32 * x]) == gen) __builtin_amdgcn_s_sleep(1);
      __builtin_amdgcn_fence(__ATOMIC_ACQUIRE, "agent");
      asm volatile("s_waitcnt vmcnt(0)" ::: "memory");
    }
  }
  __syncthreads();
}
typedef const __attribute__((address_space(4))) Params* KParams;
template <int OPC, int KINDC, bool SYNC>
DI void run_k(int L, char* shm) {
#if defined(__HIP_DEVICE_COMPILE__)
  KParams kp = (KParams)__builtin_amdgcn_kernarg_segment_ptr();
  asm volatile("" : "+s"(kp));
  const Params p = *kp;
  run_op<OPC, KINDC>(p, L, OPC, shm);
  {
    constexpr bool isA = (OPC == OP_UP1 || OPC == OP_UP2);
    constexpr bool isB = (OPC == OP_M2 && KINDC == 0) || (OPC == OP_M4 && KINDC == 2);
    constexpr bool isC = (OPC == OP_IN);
    constexpr bool isD = (OPC == OP_M1) || (OPC == OP_M3) || (OPC == OP_M2 && KINDC != 0) || (OPC == OP_M4 && KINDC == 1);
    if constexpr (((PROBE_DUP & 1) && isA) || ((PROBE_DUP & 2) && isB) || ((PROBE_DUP & 4) && isC) || ((PROBE_DUP & 8) && isD)) {
      __syncthreads();
      run_op<OPC, KINDC>(p, L, OPC, shm);
    }
  }
  if (SYNC) grid_bar((unsigned*)(p.ws + OFF_BAR), shm);
#endif
}
template <int L>
DI void run_layer(char* shm) {
  constexpr int kind = L % 3;
  run_k<OP_UP1, kind, true>(L, shm);
  run_k<OP_DN1, kind, true>(L, shm);
  run_k<OP_IN, kind, true>(L, shm);
  if constexpr (kind != 0) run_k<OP_M1, kind, true>(L, shm);
  run_k<OP_M2, kind, true>(L, shm);
  if constexpr (kind != 0) {
    run_k<OP_M3, kind, true>(L, shm);
    run_k<OP_M4, kind, true>(L, shm);
  }
  run_k<OP_OUT, kind, true>(L, shm);
  run_k<OP_UP2, kind, true>(L, shm);
  run_k<OP_DN2, kind, (L < 3)>(L, shm);
}
__global__ void __launch_bounds__(512) mega(Params pdummy, int lo, int hi, int coop) {
  extern __shared__ __attribute__((aligned(16))) char shm[];
  {
    KParams kp = (KParams)__builtin_amdgcn_kernarg_segment_ptr();
    bar_post((unsigned*)(kp->ws + OFF_BAR));
  }
  run_k<OP_INIT, -1, false>(0, shm);
  cg::this_grid().sync();
  {
    KParams kp = (KParams)__builtin_amdgcn_kernarg_segment_ptr();
    bar_setup((unsigned*)(kp->ws + OFF_BAR), shm);
  }
  run_layer<0>(shm);
  run_layer<1>(shm);
  run_layer<2>(shm);
  run_layer<3>(shm);
}
#endif
template <int OPC, int KINDC>
__global__ void __launch_bounds__(512) op_kernel(Params p, int L) {
  extern __shared__ __attribute__((aligned(16))) char shm[];
  run_op<OPC, KINDC>(p, L, OPC, shm);
}
template <int OPC, int KINDC>
static void launch_k(const Params& p, int L, int grid, size_t lds, hipStream_t stream) {
  static bool init = false;
  if (!init) { (void)hipFuncSetAttribute((const void*)op_kernel<OPC, KINDC>, hipFuncAttributeMaxDynamicSharedMemorySize, (int)lds); init = true; }
  op_kernel<OPC, KINDC><<<grid, 512, lds, stream>>>(p, L);
}
template <int OPC>
static void launch_op(const Params& p, int L, int grid, size_t lds, hipStream_t stream) {
  if constexpr (OPC == OP_IN || (OPC >= OP_M1 && OPC <= OP_M4)) {
    const int kind = L % 3;
    if (kind == 0) launch_k<OPC, 0>(p, L, grid, lds, stream);
    else if (kind == 1) launch_k<OPC, 1>(p, L, grid, lds, stream);
    else launch_k<OPC, 2>(p, L, grid, lds, stream);
  } else launch_k<OPC, -1>(p, L, grid, lds, stream);
}

extern "C" void kernel_launch(void* const* d_in, const int* in_sizes, int n_in, void* d_out, int out_size, void* d_ws, size_t ws_size,
                              hipStream_t stream) {
  constexpr size_t kDynLds = 140 * 1024;
  static int grid_blocks = 0;
  if (!grid_blocks) {
    int dev = 0, cus = 0;
    (void)hipGetDevice(&dev);
    (void)hipDeviceGetAttribute(&cus, hipDeviceAttributeMultiprocessorCount, dev);
#if MEGA
    (void)hipFuncSetAttribute((const void*)mega, hipFuncAttributeMaxDynamicSharedMemorySize, (int)kDynLds);
#endif
    grid_blocks = cus * 1;
  }
  Params p{};
  for (int i = 0; i < 32; ++i) p.in[i] = (const float*)d_in[i];
  p.out = (float*)d_out; p.ws = (char*)d_ws;
  int n = 0;
  p.prog[n++] = (0 << 4) | OP_INIT;
  for (int L = 0; L < 4; ++L) {
    const int kind = L % 3;
    p.prog[n++] = (L << 4) | OP_UP1; p.prog[n++] = (L << 4) | OP_DN1; p.prog[n++] = (L << 4) | OP_IN;
    p.prog[n++] = (L << 4) | OP_M1; p.prog[n++] = (L << 4) | OP_M2;
    if (kind != 0) { p.prog[n++] = (L << 4) | OP_M3; p.prog[n++] = (L << 4) | OP_M4; }
    p.prog[n++] = (L << 4) | OP_OUT; p.prog[n++] = (L << 4) | OP_UP2; p.prog[n++] = (L << 4) | OP_DN2;
  }
  p.nprog = n;
#if MEGA
  int lo = 0, hi = n, coop = 1;
  (void)hipMemsetAsync((char*)d_ws + OFF_BAR, 0, 8192, stream);
  void* args[] = {&p, &lo, &hi, &coop};
  hipError_t e = hipLaunchCooperativeKernel((void*)mega, dim3(grid_blocks), dim3(512), args, kDynLds, stream);
  if (e != hipSuccess) fprintf(stderr, "cooperative launch failed: %s (grid %d)\n", hipGetErrorString(e), grid_blocks);
#else
  for (int i = 0; i < n; ++i) {
    const int L = p.prog[i] >> 4, op = p.prog[i] & 15;
    switch (op) {
      case OP_INIT: launch_op<OP_INIT>(p, L, grid_blocks, kDynLds, stream); break;
      case OP_UP1: launch_op<OP_UP1>(p, L, grid_blocks, kDynLds, stream); break;
      case OP_DN1: launch_op<OP_DN1>(p, L, grid_blocks, kDynLds, stream); break;
      case OP_IN: launch_op<OP_IN>(p, L, grid_blocks, kDynLds, stream); break;
      case OP_M1: launch_op<OP_M1>(p, L, grid_blocks, kDynLds, stream); break;
      case OP_M2: launch_op<OP_M2>(p, L, grid_blocks, kDynLds, stream); break;
      case OP_M3: launch_op<OP_M3>(p, L, grid_blocks, kDynLds, stream); break;
      case OP_M4: launch_op<OP_M4>(p, L, grid_blocks, kDynLds, stream); break;
      case OP_OUT: launch_op<OP_OUT>(p, L, grid_blocks, kDynLds, stream); break;
      case OP_UP2: launch_op<OP_UP2>(p, L, grid_blocks, kDynLds, stream); break;
      case OP_DN2: launch_op<OP_DN2>(p, L, grid_blocks, kDynLds, stream); break;
    }
  }
#endif
}
```
